# Optimizing an MI355X kernel written in HIP

```python
import math
import jax, jax.numpy as jnp
from jax import lax
import numpy as np

D_MODEL = 2048
BATCH = 4
SEQ = 4096
DEPTH = 1

ATT_HEADS = 16
ATT_KV_HEADS = 2
ATT_HEAD_DIM = 64
WINDOW = 128
ATT_BLOCK = WINDOW
ATT_Q_WIDTH = ATT_HEADS * ATT_HEAD_DIM
ATT_KV_WIDTH = ATT_KV_HEADS * ATT_HEAD_DIM
GLA_HEADS = 4
GLA_DK = D_MODEL // 2
GLA_DV = D_MODEL
GLA_HEAD_K = GLA_DK // GLA_HEADS
GLA_HEAD_V = GLA_DV // GLA_HEADS
GLA_GATE_RANK = 16
GLA_GATE_TEMP = 16.0
GLA_CHUNK = 64
N_EXPERTS = 32
TOP_K = 4
D_FF = D_MODEL
SWIGLU_LIMIT = 7.0
SWIGLU_ALPHA = 1.702
MOE_BLOCK = 256
LN_EPS = 1e-5
DN_ALPHA = (2 * DEPTH) ** 0.25
DN_BETA = (8 * DEPTH) ** -0.25
IN_SPLITS = (ATT_Q_WIDTH, ATT_KV_WIDTH, ATT_KV_WIDTH,
             GLA_DK, GLA_DK, GLA_DV, GLA_DV, GLA_GATE_RANK,
             D_MODEL, D_MODEL)
IN_IS_VALUE = (False, False, True, False, False, True, False, False, False, False)
IN_COLS = sum(IN_SPLITS)

kernel_name = "hybrid_swa_gla_moe_deepnorm_adaln"


def _layernorm(x):
    xf = x.astype(jnp.float32)
    mu = jnp.mean(xf, -1, keepdims=True)
    var = jnp.mean(jnp.square(xf - mu), -1, keepdims=True)
    return ((xf - mu) * lax.rsqrt(var + LN_EPS)).astype(x.dtype)


def _layernorm_affine(x, gain, bias):
    xf = x.astype(jnp.float32)
    mu = jnp.mean(xf, -1, keepdims=True)
    var = jnp.mean(jnp.square(xf - mu), -1, keepdims=True)
    y = (xf - mu) * lax.rsqrt(var + LN_EPS) * gain.astype(jnp.float32) + bias.astype(jnp.float32)
    return y.astype(x.dtype)


def _sliding_window_attention(q, k, v, sinks):
    B, T, Hq, Dh = q.shape
    Hkv = k.shape[2]
    G = Hq // Hkv
    nb = T // ATT_BLOCK
    qb = q.reshape(B, nb, ATT_BLOCK, Hkv, G, Dh)

    def band(t):
        tb = t.reshape(B, nb, ATT_BLOCK, Hkv, Dh)
        prev = jnp.pad(tb[:, :-1], ((0, 0), (1, 0), (0, 0), (0, 0), (0, 0)))
        return jnp.concatenate([prev, tb], axis=2)

    kb, vb = band(k), band(v)
    s = jnp.einsum('bnqkgd,bnskd->bnkgqs', qb, kb,
                   preferred_element_type=jnp.float32) * (Dh ** -0.5)
    qi = jnp.arange(ATT_BLOCK)[:, None]
    si = jnp.arange(2 * ATT_BLOCK)[None, :]
    dist = qi + ATT_BLOCK - si
    blk = jnp.arange(nb)[:, None, None]
    valid = (dist >= 0) & (dist < WINDOW)
    valid = valid[None] & ((blk > 0) | (si[None] >= ATT_BLOCK))
    slopes = (2.0 ** (-8.0 * (jnp.arange(Hq, dtype=jnp.float32) + 1.0) / Hq)).reshape(Hkv, G)
    s = s - slopes[None, None, :, :, None, None] * dist.astype(jnp.float32)
    s = jnp.where(valid[None, :, None, None], s, -jnp.inf)
    sink = sinks.astype(jnp.float32).reshape(Hkv, G)[None, None, :, :, None, None]
    m = jnp.maximum(jnp.max(s, -1, keepdims=True), sink)
    p = jnp.exp(s - m)
    p = p / (jnp.sum(p, -1, keepdims=True) + jnp.exp(sink - m))
    o = jnp.einsum('bnkgqs,bnskd->bnqkgd', p.astype(v.dtype), vb)
    return o.reshape(B, T, Hq * Dh)


def _gla(q, k, v, log_a):
    B, T, H, dk = q.shape
    dv = v.shape[-1]
    C = GLA_CHUNK
    N = T // C

    def chunks(t):
        return t.astype(jnp.float32).reshape(B, N, C, H, t.shape[-1]).transpose(1, 0, 3, 2, 4)

    q = chunks(q) * (dk ** -0.5)
    k, v, g = chunks(k), chunks(v), chunks(log_a)
    b = jnp.cumsum(g, axis=3)
    b_last = b[:, :, :, -1:, :]
    q_e = q * jnp.exp(b)
    k_e = k * jnp.exp(-b)
    k_end = k * jnp.exp(b_last - b)
    causal = jnp.tril(jnp.ones((C, C), dtype=bool))
    A = jnp.where(causal, jnp.einsum('nbhid,nbhjd->nbhij', q_e, k_e), 0.0)
    o_intra = jnp.einsum('nbhij,nbhjv->nbhiv', A, v)

    def step(S, inp):
        qe, ke, vc, dl = inp
        o = jnp.einsum('bhid,bhdv->bhiv', qe, S)
        S = jnp.exp(dl)[..., None] * S + jnp.einsum('bhjd,bhjv->bhdv', ke, vc)
        return S, o

    S0 = jnp.zeros((B, H, dk, dv), jnp.float32)
    _, o_inter = lax.scan(step, S0, (q_e, k_end, v, b_last[:, :, :, 0, :]))
    o = o_intra + o_inter
    return o.transpose(1, 0, 3, 2, 4).reshape(B, T, H, dv)


def _head_rmsnorm(o, gain):
    return o * lax.rsqrt(jnp.mean(jnp.square(o), -1, keepdims=True) + LN_EPS) * gain.astype(jnp.float32)


def _moe(h, w_router, b_router, w_gate_up, b_gate_up, w_down, b_down):
    B, T, D = h.shape
    xt = h.reshape(-1, D)
    n_tok = xt.shape[0]
    logits = (xt @ w_router).astype(jnp.float32) + b_router.astype(jnp.float32)
    top_val, top_idx = lax.top_k(logits, TOP_K)
    top_w = jax.nn.softmax(top_val, axis=-1)
    n_rows = n_tok * TOP_K
    e_flat = top_idx.reshape(-1)
    w_flat = top_w.reshape(-1)
    tok_flat = jnp.arange(n_rows) // TOP_K
    order = jnp.argsort(e_flat)
    e_s, tok_s, w_s = e_flat[order], tok_flat[order], w_flat[order]
    counts = jnp.bincount(e_flat, length=N_EXPERTS)
    starts = jnp.cumsum(counts) - counts
    padded = (counts + MOE_BLOCK - 1) // MOE_BLOCK * MOE_BLOCK
    pad_end = jnp.cumsum(padded)
    pad_start = pad_end - padded
    dest = pad_start[e_s] + jnp.arange(n_rows) - starts[e_s]
    cap = -(-n_rows // MOE_BLOCK) * MOE_BLOCK + N_EXPERTS * MOE_BLOCK
    n_blocks = cap // MOE_BLOCK
    xs = jnp.zeros((cap, D), h.dtype).at[dest].set(xt[tok_s])
    blk_e = jnp.minimum(jnp.searchsorted(pad_end, jnp.arange(n_blocks) * MOE_BLOCK, side='right'),
                        N_EXPERTS - 1)

    def expert_block(args):
        xb, e = args
        gu = xb @ w_gate_up[e] + b_gate_up[e]
        gate = jnp.minimum(gu[:, 0::2], SWIGLU_LIMIT)
        up = jnp.clip(gu[:, 1::2], -SWIGLU_LIMIT, SWIGLU_LIMIT)
        act = (up + 1.0) * gate * jax.nn.sigmoid(SWIGLU_ALPHA * gate)
        return act @ w_down[e] + b_down[e]

    ys = lax.map(expert_block, (xs.reshape(n_blocks, MOE_BLOCK, D), blk_e))
    y_rows = ys.reshape(cap, D)[dest].astype(jnp.float32) * w_s[:, None]
    out = jax.ops.segment_sum(y_rows, tok_s, num_segments=n_tok)
    return out.astype(h.dtype).reshape(B, T, D)


def setup_inputs(seed: int = 0) -> dict:
    key = jax.random.key(seed)
    ks = iter(jax.random.split(key, 48))

    def nrm(shape, scale):
        return jax.random.normal(next(ks), shape, jnp.float32) * scale

    L, D, E, F = DEPTH, D_MODEL, N_EXPERTS, D_FF
    x = nrm((BATCH, SEQ, D), 1.0)
    c = nrm((BATCH, D), 1.0)
    w_ada = nrm((L, D, 6 * D), 0.5 * D ** -0.5)
    b_ada = nrm((L, 6 * D), 0.02)
    w_in = jnp.concatenate(
        [nrm((L, D, w), D ** -0.5 * (DN_BETA if is_v else 1.0))
         for w, is_v in zip(IN_SPLITS, IN_IS_VALUE)], axis=-1)
    w_gla_gate_up = nrm((L, GLA_GATE_RANK, GLA_DK), GLA_GATE_RANK ** -0.5)
    b_gla_gate = nrm((L, GLA_DK), 0.1)
    attn_sinks = nrm((L, ATT_HEADS), 1.0)
    gla_norm_gain = 1.0 + nrm((L, GLA_DV), 0.02)
    w_branch_att = nrm((L, ATT_Q_WIDTH, D), ATT_Q_WIDTH ** -0.5)
    w_branch_gla = nrm((L, GLA_DV, D), GLA_DV ** -0.5)
    w_out = nrm((L, D, D), D ** -0.5 * DN_BETA)
    ln1_gain = 1.0 + nrm((L, D), 0.02)
    ln1_bias = nrm((L, D), 0.02)
    w_router = nrm((L, D, E), D ** -0.5)
    b_router = nrm((L, E), 0.01)
    w_gate_up = nrm((L, E, D, 2 * F), D ** -0.5)
    b_gate_up = nrm((L, E, 2 * F), 0.02)
    w_down = nrm((L, E, F, D), F ** -0.5 * DN_BETA)
    b_down = nrm((L, E, D), 0.02)
    ln2_gain = 1.0 + nrm((L, D), 0.02)
    ln2_bias = nrm((L, D), 0.02)
    return {"x": x, "c": c, "w_ada": w_ada, "b_ada": b_ada, "w_in": w_in,
            "w_gla_gate_up": w_gla_gate_up, "b_gla_gate": b_gla_gate,
            "attn_sinks": attn_sinks, "gla_norm_gain": gla_norm_gain,
            "w_branch_att": w_branch_att, "w_branch_gla": w_branch_gla, "w_out": w_out,
            "ln1_gain": ln1_gain, "ln1_bias": ln1_bias,
            "w_router": w_router, "b_router": b_router,
            "w_gate_up": w_gate_up, "b_gate_up": b_gate_up,
            "w_down": w_down, "b_down": b_down,
            "ln2_gain": ln2_gain, "ln2_bias": ln2_bias}


def reference(x, c, w_ada, b_ada, w_in, w_gla_gate_up, b_gla_gate, attn_sinks, gla_norm_gain,
              w_branch_att, w_branch_gla, w_out, ln1_gain, ln1_bias, w_router, b_router,
              w_gate_up, b_gate_up, w_down, b_down, ln2_gain, ln2_bias):
    B, T, D = x.shape
    offs = np.cumsum(IN_SPLITS)[:-1].tolist()
    for l in range(DEPTH):
        ada = (jax.nn.silu(c) @ w_ada[l] + b_ada[l])[:, None, :]
        sh1, sc1, gt1, sh2, sc2, gt2 = jnp.split(ada, 6, axis=-1)

        h = _layernorm(x) * (1.0 + sc1) + sh1
        proj = h @ w_in[l]
        q_a, k_a, v_a, q_g, k_g, v_g, r_g, a_lr, g_a, g_g = jnp.split(proj, offs, axis=-1)
        y_att = _sliding_window_attention(
            q_a.reshape(B, T, ATT_HEADS, ATT_HEAD_DIM),
            k_a.reshape(B, T, ATT_KV_HEADS, ATT_HEAD_DIM),
            v_a.reshape(B, T, ATT_KV_HEADS, ATT_HEAD_DIM),
            attn_sinks[l])
        log_a = jax.nn.log_sigmoid((a_lr @ w_gla_gate_up[l] + b_gla_gate[l]).astype(jnp.float32)) / GLA_GATE_TEMP
        o_g = _gla(q_g.reshape(B, T, GLA_HEADS, GLA_HEAD_K),
                   k_g.reshape(B, T, GLA_HEADS, GLA_HEAD_K),
                   v_g.reshape(B, T, GLA_HEADS, GLA_HEAD_V),
                   log_a.reshape(B, T, GLA_HEADS, GLA_HEAD_K))
        o_g = _head_rmsnorm(o_g, gla_norm_gain[l].reshape(GLA_HEADS, GLA_HEAD_V))
        y_gla = o_g.reshape(B, T, GLA_DV).astype(x.dtype) * jax.nn.silu(r_g)
        merged = (jax.nn.sigmoid(g_a) * (y_att @ w_branch_att[l])
                  + jax.nn.sigmoid(g_g) * (y_gla @ w_branch_gla[l]))
        mix = merged @ w_out[l]
        x = _layernorm_affine(DN_ALPHA * x + gt1 * mix, ln1_gain[l], ln1_bias[l])

        h = _layernorm(x) * (1.0 + sc2) + sh2
        ffn = _moe(h, w_router[l], b_router[l], w_gate_up[l], b_gate_up[l], w_down[l], b_down[l])
        x = _layernorm_affine(DN_ALPHA * x + gt2 * ffn, ln2_gain[l], ln2_bias[l])
    return x
```

```cpp
#include <hip/hip_runtime.h>
#include <cstdio>
#include <cstdint>

#define LAS __attribute__((address_space(3)))
#define GAS __attribute__((address_space(1)))
typedef unsigned short bf16;
typedef short bf16x8 __attribute__((ext_vector_type(8)));
typedef float f32x4 __attribute__((ext_vector_type(4)));
typedef unsigned v4u __attribute__((ext_vector_type(4)));
typedef unsigned v2u __attribute__((ext_vector_type(2)));
typedef GAS unsigned gu32;

#ifndef REP_MASK
#define REP_MASK 0
#endif
#define REPN(bit) for (int rep_ = 0; rep_ < 1 + ((REP_MASK >> (bit)) & 1); ++rep_)
#ifndef FAST
#define FAST 1023
#endif
#ifndef FP8GATE
#define FP8GATE 1
#endif
#ifndef CONV_DMA
#define CONV_DMA 1
#endif
#ifndef FP8MOE
#define FP8MOE 1
#endif
#ifndef NCONV
#define NCONV 80
#endif
#ifndef MK_ONE_LAUNCH
#define MK_ONE_LAUNCH 1
#endif

constexpr int D = 2048, NB = 4, T = 4096, M = NB * T;
constexpr int AH = 16, AKV = 2, AD = 64, WIN = 128;
constexpr int GH = 4, GDK = 1024, GDV = 2048, GHK = 256, GHV = 512, GR = 16, GC = 64, GNC = T / GC;
constexpr int NE = 32, TOPK = 4, FF = 2048;
constexpr int IN_COLS = 11536;
constexpr int PJ = 11520;
constexpr int NPAD = 11776;
constexpr int C_QA = 0, C_KA = 1024, C_VA = 1152, C_QG = 1280, C_KG = 2304, C_VG = 3328, C_RG = 5376, C_GA = 7424, C_GG = 9472;
constexpr int SRC_ALR = 7424;
#ifndef FP8WO
#define FP8WO 1
#endif
#ifndef FP8PG
#define FP8PG 1
#endif
#ifndef X1BF
#define X1BF 1
#endif
#ifndef YS8
#define YS8 1
#endif
#ifndef FP8PA
#define FP8PA 1
#endif
#ifndef ALR8
#define ALR8 1
#endif
#ifndef ITEM_NBFAST
#define ITEM_NBFAST 1
#endif
#ifndef C8_LO
#define C8_LO 0
#endif
constexpr int N8 = 11520 - C8_LO, T8LO = C8_LO / 256;
constexpr float LN_EPS = 1e-5f;
constexpr float DN_ALPHA = 1.189207115002721f;
constexpr int CAP = M * TOPK + NE * 256;

constexpr size_t MiB = 1u << 20;
constexpr size_t WS_CTL = 0, CTL_ZERO_BYTES = 128 * 1024;
constexpr size_t WS_ADA = 1 * MiB, WS_HIST = 2 * MiB, WS_TOPE = 3 * MiB, WS_TOPW = 4 * MiB, WS_POS = 5 * MiB, WS_ROWW = 6 * MiB, WS_ALR = 7 * MiB, WS_DLAST = 8 * MiB;
constexpr size_t WS_AMAT = 9 * MiB, WS_PAT = 17 * MiB, WS_PGT = 21 * MiB, WS_WOT = 29 * MiB, WS_WINT = 37 * MiB, WS_H = 84 * MiB, WS_PROJ = 148 * MiB;
constexpr size_t WS_YATT = 508 * MiB, WS_QE = 540 * MiB, WS_KEND = 572 * MiB, WS_OG = 604 * MiB, WS_YGLA = 732 * MiB, WS_T1 = 796 * MiB, WS_MERGED = 924 * MiB;
constexpr size_t WS_U = 988 * MiB, WS_X1 = 1116 * MiB, WS_XS = 1244 * MiB, WS_ACT = 1532 * MiB, WS_YS = 1820 * MiB, WS_WGUT = 2108 * MiB, WS_WDNT = 2620 * MiB, WS_VAT = 2876 * MiB, WS_VGT = 2880 * MiB, WS_QEF = 2944 * MiB, WS_KEF = 2976 * MiB, WS_AMF = 3008 * MiB, WS_END = 3016 * MiB;
constexpr size_t WS_WG8 = WS_XS + 144 * MiB, WS_H8A = WS_XS + 112 * MiB;
constexpr size_t WS_PG8 = WS_XS + 184 * MiB;
constexpr size_t WS_PA8 = WS_XS + 192 * MiB;
constexpr size_t WS_WO8 = WS_XS + 176 * MiB;
constexpr size_t WS_H8 = WS_XS + 64 * MiB, WS_WGU8 = WS_WGUT, WS_WDN8 = WS_WDNT, WS_ACT8 = WS_ACT;
constexpr size_t WS_QAF = WS_XS, WS_KAF = WS_XS + 32 * MiB, WS_VAF = WS_XS + 36 * MiB;
static_assert(WS_WINT + (size_t)NPAD * D * 2 <= WS_H && WS_PROJ + (size_t)M * PJ * 2 <= WS_YATT && WS_XS + (size_t)CAP * D * 2 <= WS_ACT, "ws map");
constexpr int CW_TMO = 0, CW_BAR = 4096, CW_PAD = 16384;

constexpr int LDS_BYTES = 163840;
constexpr int MISC_OFF = 163584;

#define RLX_AGENT __ATOMIC_RELAXED, __HIP_MEMORY_SCOPE_AGENT
#define LDS_WAIT() asm volatile("s_waitcnt lgkmcnt(0)" ::: "memory")
#define VM_WAIT() asm volatile("s_waitcnt vmcnt(0)" ::: "memory")

__device__ __forceinline__ unsigned pk2(float lo, float hi) { unsigned r; asm("v_cvt_pk_bf16_f32 %0, %1, %2" : "=v"(r) : "v"(lo), "v"(hi)); return r; }
__device__ __forceinline__ unsigned f2bf(float f) { return pk2(f, 0.f) & 0xffffu; }
__device__ __forceinline__ unsigned pk4_fp8(float a, float b, float c, float d) { int p = 0; p = __builtin_amdgcn_cvt_pk_fp8_f32(a, b, p, false); p = __builtin_amdgcn_cvt_pk_fp8_f32(c, d, p, true); return (unsigned)p; }
__device__ __forceinline__ float bf2f(unsigned short b) { return __builtin_bit_cast(float, (unsigned)b << 16); }
__device__ __forceinline__ float bflo(unsigned w) { return __builtin_bit_cast(float, w << 16); }
__device__ __forceinline__ float bfhi(unsigned w) { return __builtin_bit_cast(float, w & 0xffff0000u); }
__device__ __forceinline__ float wave_sum(float v) {
#pragma unroll
    for (int o = 1; o < 64; o <<= 1) v += __shfl_xor(v, o);
    return v;
}
__device__ __forceinline__ float sigmoidf_(float x) { return __builtin_amdgcn_rcpf(1.f + __builtin_amdgcn_exp2f(-1.4426950408889634f * x)); }
__device__ __forceinline__ float siluf_(float x) { return x * sigmoidf_(x); }

#define XB_TMO      128
#define XB_XCNT(j)  (256  + 64 * (j))
#define XB_XSUB(j)  (1280 + 64 * (j))
#define XB_XGEN(j)  (2304 + 64 * (j))
#define XB_TOP      3328
#define XB_TOPGEN   3392
#define XCD_BAR_WORDS 3456
#define XB_SPIN_CAP (1u << 22)
__device__ __forceinline__ unsigned xb_ld(unsigned* p)              { return __hip_atomic_load(p, __ATOMIC_RELAXED, __HIP_MEMORY_SCOPE_AGENT); }
__device__ __forceinline__ unsigned xb_add(unsigned* p, unsigned v) { return __hip_atomic_fetch_add(p, v, __ATOMIC_RELAXED, __HIP_MEMORY_SCOPE_AGENT); }
__device__ __forceinline__ unsigned xb_xcc_id() { return (unsigned)__builtin_amdgcn_s_getreg((3 << 11) | 20) & 0xFu; }
#define XB_SPIN(cond, bar) do { unsigned _sp = 0; while (cond) { __builtin_amdgcn_s_sleep(1); \
    if ((++_sp & 255u) == 0u) { if (xb_ld(&(bar)[XB_TMO])) break; if (_sp > XB_SPIN_CAP) { atomicAdd(&(bar)[XB_TMO], 1u); break; } } } } while (0)
struct XcdBarrier { unsigned* bar; unsigned x; volatile LAS unsigned* st; };
__device__ __forceinline__ XcdBarrier xcd_barrier_post(unsigned* bar, volatile LAS unsigned* st) {
    XcdBarrier b; b.bar = bar; b.x = xb_xcc_id(); b.st = st;
    if (threadIdx.x == 0) (void)xb_add(&bar[XB_XCNT(b.x)], 1u);
    return b;
}
__device__ __forceinline__ void xcd_barrier_complete(unsigned* bar, unsigned x, unsigned& nloc, unsigned& nx) {
    const unsigned G = gridDim.x * gridDim.y * gridDim.z;
    unsigned sum, cnt, mine, sp = 0u;
    for (;;) {
        sum = 0u; cnt = 0u; mine = 0u;
#pragma unroll
        for (unsigned j = 0; j < 16; ++j) { const unsigned c = xb_ld(&bar[XB_XCNT(j)]); sum += c; cnt += (c > 0u) ? 1u : 0u; mine = (j == x) ? c : mine; }
        if (sum == G) break;
        __builtin_amdgcn_s_sleep(1);
        if ((++sp & 255u) == 0u) { if (xb_ld(&bar[XB_TMO])) break; if (sp > XB_SPIN_CAP) { atomicAdd(&bar[XB_TMO], 1u); break; } }
    }
    nloc = mine > 0u ? mine : 1u; nx = cnt > 0u ? cnt : 1u;
}
__device__ __forceinline__ void xcd_barrier(const XcdBarrier& b) {
    asm volatile("s_waitcnt vmcnt(0)" ::: "memory");
    __syncthreads();
    if (threadIdx.x == 0) {
        unsigned* bar = b.bar;
        __builtin_amdgcn_s_waitcnt(0);
        unsigned nloc = b.st[0], nx = b.st[1];
        if (nloc == 0u) { xcd_barrier_complete(bar, b.x, nloc, nx); b.st[0] = nloc; b.st[1] = nx; }
        const unsigned old = xb_add(&bar[XB_XSUB(b.x)], 1u);
        const unsigned gen = old / nloc;
        if (old + 1u == (gen + 1u) * nloc) {
            __builtin_amdgcn_fence(__ATOMIC_RELEASE, "agent");
            asm volatile("s_waitcnt vmcnt(0)" ::: "memory");
            const unsigned og = xb_add(&bar[XB_TOP], 1u);
            const unsigned tg = og / nx;
            if (og + 1u == (tg + 1u) * nx) xb_add(&bar[XB_TOPGEN], 1u);
            else XB_SPIN(xb_ld(&bar[XB_TOPGEN]) == tg, bar);
            __builtin_amdgcn_fence(__ATOMIC_ACQUIRE, "agent");
            xb_add(&bar[XB_XGEN(b.x)], 1u);
            asm volatile("s_waitcnt vmcnt(0)" ::: "memory");
        } else {
            XB_SPIN(xb_ld(&bar[XB_XGEN(b.x)]) == gen, bar);
            __builtin_amdgcn_fence(__ATOMIC_ACQUIRE, "agent");
            asm volatile("s_waitcnt vmcnt(0)" ::: "memory");
        }
    }
    __syncthreads();
}

struct Args {
    const float *x, *c, *w_ada, *b_ada, *w_in, *w_gla_up, *b_gla_gate, *sinks, *gla_gain, *w_br_att, *w_br_gla, *w_out, *ln1_g, *ln1_b,
                *w_router, *b_router, *w_gate_up, *b_gate_up, *w_down, *b_down, *ln2_g, *ln2_b;
    float* out; unsigned char* ws; int ph_lo, ph_hi;
};
struct Frame {
    LAS unsigned char* lds; int tid, lane, wave, G, bid;
};

struct STile { const bf16* A; const bf16* B0; const bf16* B1; int row0, col0, aux; };
template <bool DUAL, class Tiles, class Epi>
__device__ __forceinline__ void sgemm_phase(const Frame& F, int K, const Tiles& TL, const Epi& E) {
    const int tid = F.tid, half = tid >> 8, t256 = tid & 255, wid = (tid >> 6) & 3, lane = tid & 63, wr = wid >> 1, wc = wid & 1, fr = lane & 15, fq = lane >> 4;
    LAS unsigned char* base = F.lds + half * 32768;
    const int ntiles = TL.count();
    for (int it = 0;; ++it) {
        const int p0 = 2 * (it * F.G + F.bid);
        if (p0 >= ntiles) break;
        const int p = p0 + half; const bool valid = p < ntiles;
        STile t; TL.get(valid ? p : ntiles - 1, t);
        f32x4 acc0[4][4], acc1[4][4];
#pragma unroll
        for (int m = 0; m < 4; ++m)
#pragma unroll
            for (int n = 0; n < 4; ++n) { acc0[m][n] = (f32x4){0.f, 0.f, 0.f, 0.f}; acc1[m][n] = (f32x4){0.f, 0.f, 0.f, 0.f}; }
        for (int kt = 0; kt < K / 32; ++kt) {
#pragma unroll
            for (int i = 0; i < 2; ++i) {
                const int b = t256 * 16 + i * 4096, r = b / 64, c = (b % 64) / 2;
                const int wb = (t256 & ~63) * 16 + i * 4096;
                __builtin_amdgcn_global_load_lds((const unsigned*)(t.A + (size_t)r * K + kt * 32 + c), (LAS unsigned*)(base + wb), 16, 0, 0);
                __builtin_amdgcn_global_load_lds((const unsigned*)(t.B0 + (size_t)r * K + kt * 32 + c), (LAS unsigned*)(base + 8192 + wb), 16, 0, 0);
                if (DUAL) __builtin_amdgcn_global_load_lds((const unsigned*)(t.B1 + (size_t)r * K + kt * 32 + c), (LAS unsigned*)(base + 16384 + wb), 16, 0, 0);
            }
            asm volatile("s_waitcnt vmcnt(0)" ::: "memory"); __syncthreads();
            bf16x8 At[4], Bt0[4], Bt1[4];
#pragma unroll
            for (int m = 0; m < 4; ++m) {
                At[m] = *(const LAS bf16x8*)(base + (wr * 64 + m * 16 + fr) * 64 + fq * 16);
                Bt0[m] = *(const LAS bf16x8*)(base + 8192 + (wc * 64 + m * 16 + fr) * 64 + fq * 16);
                if (DUAL) Bt1[m] = *(const LAS bf16x8*)(base + 16384 + (wc * 64 + m * 16 + fr) * 64 + fq * 16);
            }
            asm volatile("s_waitcnt lgkmcnt(0)" ::: "memory"); __builtin_amdgcn_sched_barrier(0);
#pragma unroll
            for (int m = 0; m < 4; ++m)
#pragma unroll
                for (int n = 0; n < 4; ++n) {
                    acc0[m][n] = __builtin_amdgcn_mfma_f32_16x16x32_bf16(At[m], Bt0[n], acc0[m][n], 0, 0, 0);
                    if (DUAL) acc1[m][n] = __builtin_amdgcn_mfma_f32_16x16x32_bf16(At[m], Bt1[n], acc1[m][n], 0, 0, 0);
                }
            __syncthreads();
        }
        if (valid) {
#pragma unroll
            for (int m = 0; m < 4; ++m)
#pragma unroll
                for (int n = 0; n < 4; ++n)
#pragma unroll
                    for (int j = 0; j < 4; ++j) E(t, t.row0 + wr * 64 + m * 16 + fq * 4 + j, t.col0 + wc * 64 + n * 16 + fr, acc0[m][n][j], DUAL ? acc1[m][n][j] : 0.f);
        }
    }
}
struct DenseTiles {
    const bf16* A; const bf16* Bt; int Mr, Nc, K;
    __device__ __forceinline__ int count() const { return (Mr / 128) * (Nc / 128); }
    __device__ __forceinline__ void get(int p, STile& t) const { const int nn = Nc / 128, pm = p / nn, pn = p % nn; t.row0 = pm * 128; t.col0 = pn * 128; t.A = A + (size_t)t.row0 * K; t.B0 = Bt + (size_t)t.col0 * K; t.B1 = t.B0; t.aux = 0; }
};
struct MoeTiles {
    const bf16* A; const bf16* Bt; const int* padstart; int ncolt, K, brows; bool dualn;
    __device__ __forceinline__ int count() const { return (padstart[NE] / 128) * ncolt; }
    __device__ __forceinline__ void get(int p, STile& t) const {
        const int pm = p / ncolt, pn = p % ncolt; t.row0 = pm * 128; t.col0 = pn * 128;
        int e = 0;
#pragma unroll 1
        for (int q = 1; q < NE; ++q) if (t.row0 >= padstart[q]) e = q;
        t.aux = e; t.A = A + (size_t)t.row0 * K;
        const bf16* be = Bt + (size_t)e * brows * K;
        if (dualn) { t.B0 = be + (size_t)(pn * 256) * K; t.B1 = t.B0 + (size_t)128 * K; } else { t.B0 = be + (size_t)(pn * 128) * K; t.B1 = t.B0; }
    }
};

namespace pg8 {
#define PG8_LAS __attribute__((address_space(3)))
typedef unsigned short bf16_t;
typedef short bf16x8 __attribute__((ext_vector_type(8)));
typedef float f32x4 __attribute__((ext_vector_type(4)));
typedef unsigned u32x4 __attribute__((ext_vector_type(4)));
constexpr int BM = 256, BK = 64, HALF = 128, HTB = HALF * BK * 2  , STAGE_BYTES = 8 * HTB, NXCD = 8, WGM = 8;

__host__ __device__ __forceinline__ int lds_byte(int r, int c) { const int st = (r >> 4) * 2 + (c >> 5), rr = r & 15, cc = c & 31, ob = rr * 64 + cc * 2; return st * 1024 + (ob ^ (((ob >> 9) & 1) << 5)); }
__host__ __device__ __forceinline__ void stage_rc(int b, int& R, int& C) { const int st = b / 1024, sb = b % 1024, swz = sb ^ (((sb >> 9) & 1) << 5); R = (st >> 1) * 16 + swz / 64; C = (st & 1) * 32 + (swz % 64) / 2; }
__host__ __device__ __forceinline__ int perm32(int rho) { const int n = rho >> 4, i = rho & 15; return 8 * (i >> 2) + 4 * n + (i & 3); }

struct Unit { int pm, pn, bt, e; };
struct Gemm { const bf16_t* A; const bf16_t* Bt; int M, N, K; unsigned sa, sb; };

struct StaticOrder {
    int nM, nN, nwg, G, c;
    __host__ __device__ void init(int M, int N, int G_, int c_) { nM = M / BM; nN = N / BM; nwg = nM * nN; G = G_; c = c_; }
    __host__ __device__ bool next(int i, Unit& u) const {
        const long L = (long)i * G + c; if (L >= nwg) return false;
        int wgid = (int)L; { const int q = nwg / NXCD, r = nwg % NXCD, xcd = wgid % NXCD, off = wgid / NXCD; wgid = (xcd < r ? xcd * (q + 1) : r * (q + 1) + (xcd - r) * q) + off; }
        const int nig = WGM * nN, gid = wgid / nig, fm = gid * WGM, gsz = (nM - fm) < WGM ? (nM - fm) : WGM;
        u.pm = fm + ((wgid % nig) % gsz); u.pn = (wgid % nig) / gsz; u.bt = u.pn; u.e = 0; return true;
    }
    __device__ __forceinline__ void a_ready(const Unit&) const {}
    __device__ __forceinline__ void done(const Unit&) const {}
};

struct SkipOrder : StaticOrder {
    int t8;
    __host__ __device__ bool next(int i, Unit& u) const { if (!StaticOrder::next(i, u)) return false; if (u.pn == t8) u.pn = 45; u.bt = u.pn; return true; }
};
struct GateOrder8 : StaticOrder {
    int t8;
    __host__ __device__ bool next(int i, Unit& u) const { if (!StaticOrder::next(i, u)) return false; u.bt = u.pn; u.pn += t8; return true; }
};
__device__ __forceinline__ unsigned cvt_pk_bf16(float lo, float hi) { unsigned r; asm volatile("v_cvt_pk_bf16_f32 %0, %1, %2" : "=v"(r) : "v"(lo), "v"(hi)); return r; }
typedef float f32x2 __attribute__((ext_vector_type(2)));
typedef int v8i_t __attribute__((ext_vector_type(8)));
typedef unsigned u32x8_t __attribute__((ext_vector_type(8)));
template <class Epi, class Sched, bool ALIGN_EPI = false, bool SP2 = false, bool GATHER = false, int EB = 2>
__device__ __forceinline__ void gemm_phase(PG8_LAS unsigned char* lds, const Gemm g, const Sched& S, const Epi& E) {
    const int tid = threadIdx.x, wid = __builtin_amdgcn_readfirstlane(tid >> 6), lane = tid & 63, wr = wid >> 2, wc = wid & 3, fr = lane & 15, fq = lane >> 4;
    const int K = g.K, nt = (K * EB) / (BK * 2);
    unsigned voffA[2], voffB[2]; int RA[2]; unsigned CA2[2];
#pragma unroll
    for (int i = 0; i < 2; ++i) { int R, C; stage_rc(tid * 16 + i * 8192, R, C); const int Rb = Epi::PERM ? ((R & ~31) + perm32(R & 31)) : R;
        voffA[i] = (unsigned)(R * K * EB + C * 2); voffB[i] = (unsigned)(Rb * K * EB + C * 2); RA[i] = R; CA2[i] = (unsigned)C * 2u; }
    unsigned vo[2][2], vn[2][2];
    static_assert(!GATHER || SP2, "GATHER is written for the SP2 loop");
    const size_t kstep = (size_t)(BK * 2);
    const size_t hstep = (size_t)HALF * K * EB;
    const size_t tstep = 2 * hstep;
    const unsigned ldsw = (unsigned)wid * 1024u;
    const int ao0 = lds_byte(wr * 64 + fr, fq * 8), bo0 = lds_byte(wc * 32 + fr, fq * 8);
    constexpr int FO1 = 1024;
#define PG8_SA(b, h) (((b) * 2 + (h)) * HTB)
#define PG8_SB(b, h) ((4 + (b) * 2 + (h)) * HTB)
#define PG8_STAGE(bufoff, gbase, voff) do { _Pragma("unroll") for (int _i = 0; _i < 2; ++_i) \
        __builtin_amdgcn_global_load_lds((const unsigned*)((const char*)(gbase) + (voff)[_i]), (PG8_LAS unsigned*)(lds + (bufoff) + ldsw + _i * 8192), 16, 0, 0); } while (0)
#define PG8_STAGEA(bufoff, gbase, hf, usenext) do { if constexpr (GATHER) { unsigned vs_[2] = {(usenext) ? vn[hf][0] : vo[hf][0], (usenext) ? vn[hf][1] : vo[hf][1]}; PG8_STAGE(bufoff, gbase, vs_); } else PG8_STAGE(bufoff, (gbase) + (hf) * hstep, voffA); } while (0)
#define PG8_LDA(dst, b, h) do { _Pragma("unroll") for (int m = 0; m < 4; ++m) { if constexpr (EB == 2) { dst[m][0] = *(const PG8_LAS bf16x8*)(lds + PG8_SA(b, h) + ao0 + m * 2048); dst[m][1] = *(const PG8_LAS bf16x8*)(lds + PG8_SA(b, h) + ao0 + FO1 + m * 2048); } \
        else dst##8[m] = __builtin_shufflevector(*(const PG8_LAS u32x4*)(lds + PG8_SA(b, h) + ao0 + m * 2048), *(const PG8_LAS u32x4*)(lds + PG8_SA(b, h) + ao0 + FO1 + m * 2048), 0, 1, 2, 3, 4, 5, 6, 7); } } while (0)
#define PG8_LDB(dst, b, h) do { _Pragma("unroll") for (int n = 0; n < 2; ++n) { if constexpr (EB == 2) { dst[n][0] = *(const PG8_LAS bf16x8*)(lds + PG8_SB(b, h) + bo0 + n * 2048); dst[n][1] = *(const PG8_LAS bf16x8*)(lds + PG8_SB(b, h) + bo0 + FO1 + n * 2048); } \
        else dst##8[n] = __builtin_shufflevector(*(const PG8_LAS u32x4*)(lds + PG8_SB(b, h) + bo0 + n * 2048), *(const PG8_LAS u32x4*)(lds + PG8_SB(b, h) + bo0 + FO1 + n * 2048), 0, 1, 2, 3, 4, 5, 6, 7); } } while (0)
#define PG8_MMA(ai, bj, At, Bt) do { __builtin_amdgcn_s_setprio(1); if constexpr (EB == 2) { _Pragma("unroll") for (int m = 0; m < 4; ++m) _Pragma("unroll") for (int n = 0; n < 2; ++n) _Pragma("unroll") for (int k = 0; k < 2; ++k) \
        acc[ai][bj][m][n] = __builtin_amdgcn_mfma_f32_16x16x32_bf16(Bt[n][k], At[m][k], acc[ai][bj][m][n], 0, 0, 0); } else { asm volatile("s_nop 1"); _Pragma("unroll") for (int m = 0; m < 4; ++m) _Pragma("unroll") for (int n = 0; n < 2; ++n) \
        asm volatile("v_mfma_scale_f32_16x16x128_f8f6f4 %0, %1, %2, %0, %3, %4 op_sel_hi:[0,0,0]" : "+v"(acc[ai][bj][m][n]) : "v"(Bt##8[n]), "v"(At##8[m]), "v"(vsb), "v"(vsa)); } __builtin_amdgcn_s_setprio(0); } while (0)
#define PG8_WAIT_V(n) asm volatile("s_waitcnt vmcnt(" #n ")" ::: "memory")
#define PG8_WAIT_L(n) asm volatile("s_waitcnt lgkmcnt(" #n ")" ::: "memory")
#define PG8_BAR __builtin_amdgcn_s_barrier()
#define PG8_SCHED __builtin_amdgcn_sched_barrier(0)
    Unit cur, nxt; int ui = 0;
    if (!S.next(0, cur)) return;
    f32x4 acc[2][2][4][2];
#pragma unroll
    for (int a = 0; a < 2; ++a)
#pragma unroll
        for (int b = 0; b < 2; ++b)
#pragma unroll
            for (int m = 0; m < 4; ++m)
#pragma unroll
                for (int n = 0; n < 2; ++n) acc[a][b][m][n] = (f32x4){0.f, 0.f, 0.f, 0.f};
    unsigned vsa = g.sa, vsb = g.sb; if constexpr (EB == 1) asm volatile("" : "+v"(vsa), "+v"(vsb));
    bf16x8 At[4][2], B0[2][2], B1[2][2]; u32x8_t At8[4], B08[2], B18[2];
    const char* cA = GATHER ? (const char*)g.A : (const char*)g.A + (size_t)cur.pm * tstep; const char* cB = (const char*)g.Bt + (size_t)cur.bt * tstep;
    if constexpr (GATHER) {
#pragma unroll
        for (int hf = 0; hf < 2; ++hf)
#pragma unroll
            for (int i = 0; i < 2; ++i) { vo[hf][i] = S.gtab[hf * HALF + RA[i]] + CA2[i]; vn[hf][i] = vo[hf][i]; } }
    S.a_ready(cur);
    if constexpr (SP2) {
        PG8_STAGE(PG8_SB(0, 0), cB, voffB); PG8_STAGE(PG8_SB(0, 1), cB + hstep, voffB); PG8_STAGEA(PG8_SA(0, 0), cA, 0, false); PG8_STAGEA(PG8_SA(0, 1), cA, 1, false);
        if (wr == 1) PG8_BAR;
        PG8_WAIT_V(2); PG8_BAR;
        PG8_STAGE(PG8_SB(1, 0), cB + kstep, voffB); PG8_STAGEA(PG8_SA(1, 0), cA + kstep, 0, false); PG8_STAGE(PG8_SB(1, 1), cB + hstep + kstep, voffB);
        PG8_WAIT_V(6); PG8_BAR;
    } else {
        PG8_STAGE(PG8_SB(0, 0), cB, voffB); PG8_STAGE(PG8_SA(0, 0), cA, voffA); PG8_STAGE(PG8_SB(0, 1), cB + hstep, voffB); PG8_STAGE(PG8_SA(0, 1), cA + hstep, voffA);
        if (wr == 1) PG8_BAR;
        PG8_WAIT_V(4); PG8_BAR;
        PG8_STAGE(PG8_SB(1, 0), cB + kstep, voffB); PG8_STAGE(PG8_SA(1, 0), cA + kstep, voffA); PG8_STAGE(PG8_SB(1, 1), cB + hstep + kstep, voffB);
        PG8_WAIT_V(6); PG8_BAR;
    }
    for (;;) {
        const bool has_next = S.next(ui + 1, nxt);
        const char* nA = (has_next && !GATHER) ? (const char*)g.A + (size_t)nxt.pm * tstep : cA;
        if constexpr (GATHER) {
#pragma unroll
            for (int hf = 0; hf < 2; ++hf)
#pragma unroll
                for (int i = 0; i < 2; ++i) vn[hf][i] = has_next ? S.gtab[(ui + 1) * BM + hf * HALF + RA[i]] + CA2[i] : vo[hf][i]; } const char* nB = has_next ? (const char*)g.Bt + (size_t)nxt.bt * tstep : cB;
        for (int t = 0; t < nt; t += 2) {
            const bool last = (t == nt - 2);
            const char* a1 = cA + (size_t)(t + 1) * kstep;
            const char* a2 = last ? nA : cA + (size_t)(t + 2) * kstep; const char* b2 = last ? nB : cB + (size_t)(t + 2) * kstep;
            const char* a3 = a2 + kstep; const char* b3 = b2 + kstep;
            if (last && has_next) S.a_ready(nxt);
            if constexpr (SP2) {
            PG8_LDB(B0, 0, 0); PG8_LDB(B1, 0, 1); PG8_SCHED; PG8_LDA(At, 0, 0); PG8_STAGEA(PG8_SA(1, 1), a1, 1, false);
            PG8_WAIT_V(8); PG8_WAIT_L(0); PG8_BAR; PG8_MMA(0, 0, At, B0); PG8_MMA(0, 1, At, B1); PG8_BAR; PG8_SCHED;
            PG8_LDA(At, 0, 1); PG8_STAGE(PG8_SB(0, 0), b2, voffB); PG8_STAGE(PG8_SB(0, 1), b2 + hstep, voffB); PG8_STAGEA(PG8_SA(0, 0), a2, 0, last);
            PG8_WAIT_V(8); PG8_WAIT_L(0); PG8_BAR; PG8_MMA(1, 0, At, B0); PG8_MMA(1, 1, At, B1); PG8_BAR; PG8_SCHED;
            PG8_LDB(B0, 1, 0); PG8_LDB(B1, 1, 1); PG8_SCHED; PG8_LDA(At, 1, 0); PG8_STAGEA(PG8_SA(0, 1), a2, 1, last);
            PG8_WAIT_V(8); PG8_WAIT_L(0); PG8_BAR; PG8_MMA(0, 0, At, B0); PG8_MMA(0, 1, At, B1); PG8_BAR; PG8_SCHED;
            PG8_LDA(At, 1, 1); PG8_STAGE(PG8_SB(1, 0), b3, voffB); PG8_STAGE(PG8_SB(1, 1), b3 + hstep, voffB); PG8_STAGEA(PG8_SA(1, 0), a3, 0, last);
            PG8_WAIT_V(8); PG8_WAIT_L(0); PG8_BAR; PG8_MMA(1, 0, At, B0); PG8_MMA(1, 1, At, B1); PG8_BAR; PG8_SCHED;
            } else {
            PG8_LDB(B0, 0, 0); PG8_SCHED; PG8_LDA(At, 0, 0); PG8_STAGE(PG8_SA(1, 1), a1 + hstep, voffA);
            PG8_WAIT_L(8); PG8_BAR; PG8_WAIT_L(0); PG8_MMA(0, 0, At, B0); PG8_BAR; PG8_SCHED;
            PG8_LDB(B1, 0, 1); PG8_STAGE(PG8_SB(0, 0), b2, voffB);
            PG8_BAR; PG8_WAIT_L(0); PG8_MMA(0, 1, At, B1); PG8_BAR;
            PG8_LDA(At, 0, 1); PG8_STAGE(PG8_SA(0, 0), a2, voffA);
            PG8_BAR; PG8_WAIT_L(0); PG8_MMA(1, 0, At, B0); PG8_BAR; PG8_SCHED;
            PG8_STAGE(PG8_SB(0, 1), b2 + hstep, voffB);
            PG8_WAIT_V(6); PG8_BAR; PG8_MMA(1, 1, At, B1); PG8_BAR;
            PG8_LDB(B0, 1, 0); PG8_SCHED; PG8_LDA(At, 1, 0); PG8_STAGE(PG8_SA(0, 1), a2 + hstep, voffA);
            PG8_WAIT_L(8); PG8_BAR; PG8_WAIT_L(0); PG8_MMA(0, 0, At, B0); PG8_BAR; PG8_SCHED;
            PG8_LDB(B1, 1, 1); PG8_STAGE(PG8_SB(1, 0), b3, voffB);
            PG8_BAR; PG8_WAIT_L(0); PG8_MMA(0, 1, At, B1); PG8_BAR;
            PG8_LDA(At, 1, 1); PG8_STAGE(PG8_SA(1, 0), a3, voffA);
            PG8_BAR; PG8_WAIT_L(0); PG8_MMA(1, 0, At, B0); PG8_BAR; PG8_SCHED;
            PG8_STAGE(PG8_SB(1, 1), b3 + hstep, voffB);
            PG8_WAIT_V(6); PG8_BAR; PG8_MMA(1, 1, At, B1); PG8_BAR;
            }
        }
        if constexpr (EB == 1) {
            asm volatile("s_nop 15\n\ts_nop 15" ::: "memory");
#pragma unroll
            for (int a_ = 0; a_ < 2; ++a_)
#pragma unroll
                for (int b_ = 0; b_ < 2; ++b_)
#pragma unroll
                    for (int m_ = 0; m_ < 4; ++m_) asm volatile("" : "+v"(acc[a_][b_][m_][0]), "+v"(acc[a_][b_][m_][1]));
        }
        if constexpr (ALIGN_EPI) { if (wr == 0) PG8_BAR; }
        if constexpr (!Epi::AFTER_DRAIN) { E(acc, cur, wr, wc, fr, fq); S.done(cur); }
        if (!has_next) break;
#pragma unroll
        for (int a = 0; a < 2; ++a)
#pragma unroll
            for (int b = 0; b < 2; ++b)
#pragma unroll
                for (int m = 0; m < 4; ++m)
#pragma unroll
                    for (int n = 0; n < 2; ++n) acc[a][b][m][n] = (f32x4){0.f, 0.f, 0.f, 0.f};
        cur = nxt; cA = nA; cB = nB; ++ui;
        if constexpr (GATHER) {
#pragma unroll
            for (int hf = 0; hf < 2; ++hf)
#pragma unroll
                for (int i = 0; i < 2; ++i) vo[hf][i] = vn[hf][i]; }
        if constexpr (ALIGN_EPI) { if (wr == 1) PG8_BAR; }
    }
    PG8_WAIT_V(0);
    if constexpr (!ALIGN_EPI) { if (wr == 0) PG8_BAR; }
    PG8_BAR;
    if constexpr (Epi::AFTER_DRAIN) { E.fused(acc, cur, wr, wc, fr, fq, lds, wid, lane); S.done(cur); }
#undef PG8_SA
#undef PG8_SB
#undef PG8_STAGE
#undef PG8_STAGEA
#undef PG8_LDA
#undef PG8_LDB
#undef PG8_MMA
#undef PG8_WAIT_V
#undef PG8_WAIT_L
#undef PG8_BAR
#undef PG8_SCHED
}
}

namespace pg8 {
__device__ __forceinline__ u32x4 pack8(f32x4 v0, f32x4 v1) { u32x4 w; w.x = cvt_pk_bf16(v0[0], v0[1]); w.y = cvt_pk_bf16(v0[2], v0[3]); w.z = cvt_pk_bf16(v1[0], v1[1]); w.w = cvt_pk_bf16(v1[2], v1[3]); return w; }
__device__ __forceinline__ void unpack8(u32x4 w, f32x4& v0, f32x4& v1) { v0 = (f32x4){bflo(w.x), bfhi(w.x), bflo(w.y), bfhi(w.y)}; v1 = (f32x4){bflo(w.z), bfhi(w.z), bflo(w.w), bfhi(w.w)}; }
__device__ __forceinline__ f32x4 sig4(f32x4 v) { return (f32x4){sigmoidf_(v[0]), sigmoidf_(v[1]), sigmoidf_(v[2]), sigmoidf_(v[3])}; }
__device__ __forceinline__ f32x4 silu4(f32x4 v) { return (f32x4){siluf_(v[0]), siluf_(v[1]), siluf_(v[2]), siluf_(v[3])}; }
struct EpiProjF { static constexpr bool PERM = true, AFTER_DRAIN = false; bf16_t* proj; float* alr; bf16_t* qaf; bf16_t* kaf; bf16_t* vaf; bf16_t* vgt;
    __device__ __forceinline__ void operator()(const f32x4 (&acc)[2][2][4][2], const Unit& u, int wr, int wc, int fr, int fq) const {
        const int row0 = u.pm * BM + wr * 64 + fr, colt = u.pn * BM;
        if (colt >= PJ) {
            if (wc == 0 && fq < 2) {
#pragma unroll
                for (int ai = 0; ai < 2; ++ai)
#pragma unroll
                    for (int m = 0; m < 4; ++m) { float* p = alr + (size_t)(row0 + ai * HALF + m * 16) * GR + 8 * fq; *(f32x4*)p = acc[ai][0][m][0]; *(f32x4*)(p + 4) = acc[ai][0][m][1]; }
            }
            return;
        }
        if (colt < C_QG) {
            const int sfr = (wc & 1) * 2 + (fq >> 1), hfr = fq & 1;
#pragma unroll
            for (int ai = 0; ai < 2; ++ai)
#pragma unroll
                for (int m = 0; m < 4; ++m) { const int r = row0 + ai * HALF + m * 16, b = r / T, ts = r % T, qt = ts >> 5, nt = ts & 31;
#pragma unroll
                    for (int bj = 0; bj < 2; ++bj) {
                        if (colt < C_KA) { const int hq = colt / 64 + bj * 2 + (wc >> 1);
                            *(u32x4*)(qaf + (((((size_t)(b * AH + hq) * (T / 32) + qt) * 4 + sfr) * 64 + hfr * 32 + nt) << 3)) = pack8(acc[ai][bj][m][0], acc[ai][bj][m][1]); }
                        else if (bj == 0) { const int kh = wc >> 1;
                            *(u32x4*)(kaf + (((((size_t)(b * AKV + kh) * (T / 32) + qt) * 4 + sfr) * 64 + hfr * 32 + nt) << 3)) = pack8(acc[ai][0][m][0], acc[ai][0][m][1]); }
                        else { const int kh = wc >> 1, s2 = nt >> 4, r16 = nt & 15, jj = 4 * (r16 >> 3) + (r16 & 3), hh = (r16 >> 2) & 1;
                            bf16_t* vp = vaf + ((((((size_t)(b * AKV + kh) * (T / 32) + qt) * 2 + (wc & 1)) * 2 + s2) * 64 + hh * 32 + 8 * fq) << 3) + jj;
#pragma unroll
                            for (int n = 0; n < 2; ++n)
#pragma unroll
                                for (int j = 0; j < 4; ++j) vp[(4 * n + j) * 8] = (bf16_t)f2bf(acc[ai][1][m][n][j]); }
                    } }
            return;
        }
        const int act = colt >= C_GA ? 2 : (colt >= C_RG ? 1 : 0);
        const int col0 = colt + wc * 32 + 8 * fq;
        if (colt >= C_VG && colt < C_RG) {
            const int hd = (colt - C_VG) / GHV, sl0 = ((colt - C_VG) % GHV) / 32 + wc;
#pragma unroll
            for (int ai = 0; ai < 2; ++ai)
#pragma unroll
                for (int m = 0; m < 4; ++m) { const int r = row0 + ai * HALF + m * 16, b = r / T, ts = r % T, t = ts & 63; const int uu = (b * GH + hd) * GNC + (ts >> 6);
#pragma unroll
                    for (int bj = 0; bj < 2; ++bj) { bf16_t* vp = vgt + ((((size_t)uu * 16 + sl0 + 4 * bj) * 4 + (t >> 4)) * 64 + ((t >> 3) & 1) * 32 + 8 * fq) * 8 + (t & 7);
#pragma unroll
                        for (int n = 0; n < 2; ++n)
#pragma unroll
                            for (int j = 0; j < 4; ++j) vp[(4 * n + j) * 8] = (bf16_t)f2bf(acc[ai][bj][m][n][j]); } }
#if FAST & 128
            return;
#endif
        }
#pragma unroll
        for (int ai = 0; ai < 2; ++ai)
#pragma unroll
            for (int m = 0; m < 4; ++m) { bf16_t* rowp = proj + (size_t)(row0 + ai * HALF + m * 16) * PJ + col0;
#pragma unroll
                for (int bj = 0; bj < 2; ++bj) { f32x4 v0 = acc[ai][bj][m][0], v1 = acc[ai][bj][m][1];
                    if (act == 1) { v0 = silu4(v0); v1 = silu4(v1); } else if (act == 2) { v0 = sig4(v0); v1 = sig4(v1); }
                    *(u32x4*)(rowp + bj * HALF) = pack8(v0, v1); } }
    }
};
struct EpiT1F { static constexpr bool PERM = true, AFTER_DRAIN = false; const bf16_t* proj; bf16_t* t1;
    __device__ __forceinline__ void operator()(const f32x4 (&acc)[2][2][4][2], const Unit& u, int wr, int wc, int fr, int fq) const {
        const int row0 = u.pm * BM + wr * 64 + fr, col0 = u.pn * BM + wc * 32 + 8 * fq;
#pragma unroll
        for (int ai = 0; ai < 2; ++ai)
#pragma unroll
            for (int m = 0; m < 4; ++m) { const size_t row = (size_t)(row0 + ai * HALF + m * 16);
#pragma unroll
                for (int bj = 0; bj < 2; ++bj) { f32x4 g0, g1; unpack8(*(const u32x4*)(proj + row * PJ + C_GA + col0 + bj * HALF), g0, g1);
                    *(u32x4*)(t1 + row * D + col0 + bj * HALF) = pack8(acc[ai][bj][m][0] * g0, acc[ai][bj][m][1] * g1); } }
    }
};
struct EpiMergedF { static constexpr bool PERM = true, AFTER_DRAIN = false; const bf16_t* proj; const bf16_t* t1; bf16_t* mg;
    __device__ __forceinline__ void operator()(const f32x4 (&acc)[2][2][4][2], const Unit& u, int wr, int wc, int fr, int fq) const {
        const int row0 = u.pm * BM + wr * 64 + fr, col0 = u.pn * BM + wc * 32 + 8 * fq;
#pragma unroll
        for (int ai = 0; ai < 2; ++ai)
#pragma unroll
            for (int m = 0; m < 4; ++m) { const size_t row = (size_t)(row0 + ai * HALF + m * 16);
#pragma unroll
                for (int bj = 0; bj < 2; ++bj) { f32x4 g0, g1; unpack8(*(const u32x4*)(proj + row * PJ + C_GG + col0 + bj * HALF), g0, g1);
                    f32x4 a0, a1; unpack8(*(const u32x4*)(t1 + row * D + col0 + bj * HALF), a0, a1);
                    const f32x4 r0 = a0 + acc[ai][bj][m][0] * g0, r1 = a1 + acc[ai][bj][m][1] * g1;
#if FP8WO
                    v2u w; w.x = pk4_fp8(16.f * r0[0], 16.f * r0[1], 16.f * r0[2], 16.f * r0[3]); w.y = pk4_fp8(16.f * r1[0], 16.f * r1[1], 16.f * r1[2], 16.f * r1[3]);
                    *(v2u*)((unsigned char*)mg + row * D + col0 + bj * HALF) = w; } }
#else
                    *(u32x4*)(mg + row * D + col0 + bj * HALF) = pack8(r0, r1); } }
#endif
    }
};
struct EpiUF { static constexpr bool PERM = true, AFTER_DRAIN = false; const float* ada; bf16_t* mixg;
    __device__ __forceinline__ void operator()(const f32x4 (&acc)[2][2][4][2], const Unit& u, int wr, int wc, int fr, int fq) const {
        const int row0 = u.pm * BM + wr * 64 + fr, col0 = u.pn * BM + wc * 32 + 8 * fq; const float* gt = ada + ((u.pm * BM) / T) * 6 * D + 2 * D;
#pragma unroll
        for (int bj = 0; bj < 2; ++bj) { const f32x4 g0 = *(const f32x4*)(gt + col0 + bj * HALF), g1 = *(const f32x4*)(gt + col0 + bj * HALF + 4);
#pragma unroll
            for (int ai = 0; ai < 2; ++ai)
#pragma unroll
                for (int m = 0; m < 4; ++m) *(u32x4*)(mixg + (size_t)(row0 + ai * HALF + m * 16) * D + col0 + bj * HALF) = pack8(g0 * acc[ai][bj][m][0], g1 * acc[ai][bj][m][1]); }
    }
};
struct EpiSwigluF { static constexpr bool PERM = true, AFTER_DRAIN = false; const float* bgu; bf16_t* act;
    __device__ __forceinline__ void operator()(const f32x4 (&acc)[2][2][4][2], const Unit& u, int wr, int wc, int fr, int fq) const {
        const int row0 = u.pm * BM + wr * 64 + fr, c0 = u.pn * HALF + wc * 32 + 8 * fq;
        const float* be = bgu + (size_t)u.e * 2 * FF + 2 * c0;
        const f32x4 f0 = *(const f32x4*)be, f1 = *(const f32x4*)(be + 4), f2 = *(const f32x4*)(be + 8), f3 = *(const f32x4*)(be + 12);
        const f32x4 bg0 = (f32x4){f0.x, f0.z, f1.x, f1.z}, bu0 = (f32x4){f0.y, f0.w, f1.y, f1.w}, bg1 = (f32x4){f2.x, f2.z, f3.x, f3.z}, bu1 = (f32x4){f2.y, f2.w, f3.y, f3.w};
#pragma unroll
        for (int ai = 0; ai < 2; ++ai)
#pragma unroll
            for (int m = 0; m < 4; ++m) { f32x4 r[2];
#pragma unroll
                for (int n = 0; n < 2; ++n) { const f32x4 g = acc[ai][0][m][n] + (n ? bg1 : bg0), up = acc[ai][1][m][n] + (n ? bu1 : bu0);
#pragma unroll
                    for (int j = 0; j < 4; ++j) { const float gg = fminf(g[j], 7.f), uu = fminf(fmaxf(up[j], -7.f), 7.f); r[n][j] = (uu + 1.f) * gg * __builtin_amdgcn_rcpf(1.f + __builtin_amdgcn_exp2f(-2.4554669595930157f * gg)); } }
                *(u32x4*)(act + (size_t)(row0 + ai * HALF + m * 16) * FF + c0) = pack8(r[0], r[1]); }
    }
};
struct EpiSwiglu8 { static constexpr bool PERM = true, AFTER_DRAIN = false; const float* bgu; unsigned char* act;
    __device__ __forceinline__ void operator()(const f32x4 (&acc)[2][2][4][2], const Unit& u, int wr, int wc, int fr, int fq) const {
        const int row0 = u.pm * BM + wr * 64 + fr, c0 = u.pn * HALF + wc * 32 + 8 * fq;
        const float* be = bgu + (size_t)u.e * 2 * FF + 2 * c0;
        const f32x4 f0 = *(const f32x4*)be, f1 = *(const f32x4*)(be + 4), f2 = *(const f32x4*)(be + 8), f3 = *(const f32x4*)(be + 12);
        const f32x4 bg0 = (f32x4){f0.x, f0.z, f1.x, f1.z}, bu0 = (f32x4){f0.y, f0.w, f1.y, f1.w}, bg1 = (f32x4){f2.x, f2.z, f3.x, f3.z}, bu1 = (f32x4){f2.y, f2.w, f3.y, f3.w};
#pragma unroll
        for (int ai = 0; ai < 2; ++ai)
#pragma unroll
            for (int m = 0; m < 4; ++m) { f32x4 r[2];
#pragma unroll
                for (int n = 0; n < 2; ++n) { const f32x4 g = acc[ai][0][m][n] + (n ? bg1 : bg0), up = acc[ai][1][m][n] + (n ? bu1 : bu0);
#pragma unroll
                    for (int j = 0; j < 4; ++j) { const float gg = fminf(g[j], 7.f), uu = fminf(fmaxf(up[j], -7.f), 7.f); r[n][j] = 4.f * (uu + 1.f) * gg * __builtin_amdgcn_rcpf(1.f + __builtin_amdgcn_exp2f(-2.4554669595930157f * gg)); } }
                v2u w; w.x = pk4_fp8(r[0][0], r[0][1], r[0][2], r[0][3]); w.y = pk4_fp8(r[1][0], r[1][1], r[1][2], r[1][3]);
                *(v2u*)(act + (size_t)(row0 + ai * HALF + m * 16) * FF + c0) = w; }
    }
};
struct EpiDownF { static constexpr bool PERM = true, AFTER_DRAIN = false; const float* bd; const float* roww; bf16_t* ys;
    __device__ __forceinline__ void operator()(const f32x4 (&acc)[2][2][4][2], const Unit& u, int wr, int wc, int fr, int fq) const {
        const int row0 = u.pm * BM + wr * 64 + fr, col0 = u.pn * BM + wc * 32 + 8 * fq; const float* be = bd + (size_t)u.e * D + col0;
        f32x4 b[2][2];
#pragma unroll
        for (int bj = 0; bj < 2; ++bj) { b[bj][0] = *(const f32x4*)(be + bj * HALF); b[bj][1] = *(const f32x4*)(be + bj * HALF + 4); }
#pragma unroll
        for (int ai = 0; ai < 2; ++ai)
#pragma unroll
            for (int m = 0; m < 4; ++m) { const size_t row = (size_t)(row0 + ai * HALF + m * 16); const float w = roww[row];
#pragma unroll
                for (int bj = 0; bj < 2; ++bj) {
#if YS8
                    const f32x4 r0 = (acc[ai][bj][m][0] + b[bj][0]) * (16.f * w), r1 = (acc[ai][bj][m][1] + b[bj][1]) * (16.f * w);
                    v2u w8; w8.x = pk4_fp8(r0[0], r0[1], r0[2], r0[3]); w8.y = pk4_fp8(r1[0], r1[1], r1[2], r1[3]);
                    *(v2u*)((unsigned char*)ys + row * D + col0 + bj * HALF) = w8; }
#else
                    *(u32x4*)(ys + row * D + col0 + bj * HALF) = pack8((acc[ai][bj][m][0] + b[bj][0]) * w, (acc[ai][bj][m][1] + b[bj][1]) * w); }
#endif
            }
    }
};
struct MoeOrder : StaticOrder {
    int NT; const PG8_LAS unsigned char* t2e; const PG8_LAS unsigned* gtab;
    __device__ __forceinline__ bool next(int i, Unit& u) const { if (!StaticOrder::next(i, u)) return false; u.e = __builtin_amdgcn_readfirstlane((int)t2e[u.pm]); u.bt = u.e * NT + u.pn; return true; }
};
}

template <class RowMap>
__device__ __forceinline__ void transpose_item(const float* W, int K, int N, bf16* WT, LAS float* scr, int kb, int nb, int lane, const RowMap& rm) {
    const int k0 = 64 * kb, n0 = 32 * nb;
    const int nsrc = n0 + (lane & 31);
#pragma unroll 8
    for (int i = 0; i < 32; ++i) { const int kk = 2 * i + (lane >> 5); scr[kk * 33 + (lane & 31)] = (nsrc < N) ? W[(size_t)(k0 + kk) * N + nsrc] : 0.f; }
    LDS_WAIT(); asm volatile("" ::: "memory");
    const int c = lane & 7;
#pragma unroll
    for (int j = 0; j < 4; ++j) { const int n = (lane >> 3) + 8 * j; const LAS float* s = scr + (8 * c) * 33 + n;
        v4u o; o.x = pk2(s[0 * 33], s[1 * 33]); o.y = pk2(s[2 * 33], s[3 * 33]); o.z = pk2(s[4 * 33], s[5 * 33]); o.w = pk2(s[6 * 33], s[7 * 33]);
        if (n0 + n < N) *(GAS v4u*)(WT + (size_t)rm(n0 + n) * K + k0 + 8 * c) = o; }
    LDS_WAIT(); asm volatile("" ::: "memory");
}
struct RmIdent { __device__ __forceinline__ int operator()(int n) const { return n; } };
#if FP8GATE
struct RmWin { __device__ __forceinline__ int operator()(int n) const { return n < C8_LO ? n : (n >= SRC_ALR && n < SRC_ALR + GR ? PJ + (n - SRC_ALR) : -1); } };
#else
struct RmWin { __device__ __forceinline__ int operator()(int n) const { return n < SRC_ALR ? n : (n < SRC_ALR + GR ? PJ + (n - SRC_ALR) : n - GR); } };
#endif
struct RmGateUp { __device__ __forceinline__ int operator()(int n) const { const int j = n >> 1, up = n & 1; return (j >> 7) * 256 + up * 128 + (j & 127); } };

template <class RowMap>
__device__ __forceinline__ void transpose_item2(const float* W, int K, int N, bf16* WT, LAS unsigned* scr, int kb2, int nb, int lane, const RowMap& rm) {
    const int n0 = 128 * nb, hh = lane >> 5, n4 = (lane & 31) * 4; const bool ok = n0 + n4 < N;
#pragma unroll 1
    for (int sub = 0; sub < 2; ++sub) {
        const int k0 = 64 * kb2 + 32 * sub;
        f32x4 v[16];
        const float* wp = W + (size_t)(k0 + 16 * hh) * N + n0 + n4;
#pragma unroll
        for (int i = 0; i < 16; ++i) v[i] = ok ? *(const GAS f32x4*)(wp + (size_t)i * N) : (f32x4){0.f, 0.f, 0.f, 0.f};
#pragma unroll
        for (int ip = 0; ip < 8; ++ip)
#pragma unroll
            for (int c = 0; c < 4; ++c) scr[(n4 + c) * 17 + 8 * hh + ip] = pk2(v[2 * ip][c], v[2 * ip + 1][c]);
        LDS_WAIT(); asm volatile("" ::: "memory");
#pragma unroll
        for (int j = 0; j < 8; ++j) { const int n = (lane >> 2) + 16 * j, q = lane & 3; const LAS unsigned* sp = scr + n * 17 + 4 * q;
            const v4u o = (v4u){sp[0], sp[1], sp[2], sp[3]};
            const int drow = (n0 + n < N) ? rm(n0 + n) : -1;
            if (drow >= 0) *(GAS v4u*)(WT + (size_t)drow * K + k0 + 8 * q) = o; }
        LDS_WAIT(); asm volatile("" ::: "memory");
    }
}
struct SubT { const float* src; bf16* dst; int N, n0, gu; };
__device__ __forceinline__ SubT moe_subtile(const Args& a, unsigned char* ws, int it) {
    constexpr int I_GU = 32 * 64, I_DN = 32 * 32;
    SubT t;
    if (it < NE * I_GU) { const int e = it / I_GU, r = it % I_GU, kb = ITEM_NBFAST ? 2 * ((r >> 1) / 64) + (r & 1) : r % 32, nb = ITEM_NBFAST ? (r >> 1) % 64 : r / 32, k0 = 64 * kb; t.N = 2 * FF; t.n0 = 64 * nb; t.gu = 1;
        t.src = a.w_gate_up + (size_t)e * D * 2 * FF + (size_t)k0 * (2 * FF) + t.n0;
        t.dst = FP8MOE ? (bf16*)(ws + WS_WGU8 + (size_t)e * 2 * FF * D + k0) : (bf16*)(ws + WS_WGUT) + (size_t)e * 2 * FF * D + k0; }
    else { const int i2 = it - NE * I_GU, e = i2 / I_DN, r = i2 % I_DN, kb = ITEM_NBFAST ? 2 * ((r >> 1) / 32) + (r & 1) : r % 32, nb = ITEM_NBFAST ? (r >> 1) % 32 : r / 32, k0 = 64 * kb; t.N = D; t.n0 = 64 * nb; t.gu = 0;
        t.src = a.w_down + (size_t)e * FF * D + (size_t)k0 * D + t.n0;
        t.dst = FP8MOE ? (bf16*)(ws + WS_WDN8 + (size_t)e * D * FF + k0) : (bf16*)(ws + WS_WDNT) + (size_t)e * D * FF + k0; }
    return t;
}
__device__ __forceinline__ void subt_load(const SubT& t, int lane, f32x4 (&v)[16]) {
    const float* wp = t.src + (size_t)(16 * (lane >> 4)) * t.N + (lane & 15) * 4;
#pragma unroll
    for (int i = 0; i < 16; ++i) v[i] = __builtin_nontemporal_load((const f32x4*)(wp + (size_t)i * t.N));
}
__device__ __forceinline__ void subt_store(const SubT& t, int lane, const f32x4 (&v)[16], LAS unsigned* scr) {
    const int g = lane >> 4, n4 = (lane & 15) * 4;
#pragma unroll
    for (int ip = 0; ip < 8; ++ip)
#pragma unroll
        for (int c = 0; c < 4; ++c) scr[(n4 + c) * 33 + 8 * g + ip] = pk2(v[2 * ip][c], v[2 * ip + 1][c]);
    LDS_WAIT(); asm volatile("" ::: "memory");
#pragma unroll
    for (int j = 0; j < 8; ++j) { const int n = (lane >> 3) + 8 * j, q = lane & 7, ng = t.n0 + n; const LAS unsigned* sp = scr + n * 33 + 4 * q;
        const v4u o = (v4u){sp[0], sp[1], sp[2], sp[3]};
        const int row = t.gu ? ((ng >> 8) * 256 + (ng & 1) * 128 + ((ng >> 1) & 127)) : ng;
        __builtin_nontemporal_store(o, (v4u*)(t.dst + (size_t)row * D + 8 * q)); }
    LDS_WAIT(); asm volatile("" ::: "memory");
}
#if FP8MOE
__device__ __forceinline__ void subt_store8(const SubT& t, int lane, const f32x4 (&v)[16], LAS unsigned* scr, int pitch = D) {
    const int g = lane >> 4, n4 = (lane & 15) * 4;
#pragma unroll
    for (int p = 0; p < 4; ++p)
#pragma unroll
        for (int c = 0; c < 4; ++c) scr[(n4 + c) * 17 + 4 * g + p] = pk4_fp8(v[4 * p][c] * 64.f, v[4 * p + 1][c] * 64.f, v[4 * p + 2][c] * 64.f, v[4 * p + 3][c] * 64.f);
    LDS_WAIT(); asm volatile("" ::: "memory");
#pragma unroll
    for (int j = 0; j < 4; ++j) { const int n = (lane >> 2) + 16 * j, q = lane & 3, ng = t.n0 + n; const LAS unsigned* sp = scr + n * 17 + 4 * q;
        const v4u o = (v4u){sp[0], sp[1], sp[2], sp[3]};
        const int row = t.gu ? ((ng >> 8) * 256 + (ng & 1) * 128 + ((ng >> 1) & 127)) : ng;
        *(GAS v4u*)((unsigned char*)t.dst + (size_t)row * pitch + 16 * q) = o; }
    LDS_WAIT(); asm volatile("" ::: "memory");
}
#endif
__device__ __forceinline__ void phase_prologue(const Frame& F, const Args& a) {
    unsigned char* ws = a.ws;
    {
        LAS float* sc = (LAS float*)(F.lds);
        LAS float* part = (LAS float*)(F.lds + 32768);
        for (int i = F.tid; i < NB * D; i += 512) sc[i] = siluf_(a.c[i]);
        __syncthreads();
        float* ada = (float*)(ws + WS_ADA);
        for (int u = F.bid; u < 6 * D / 64; u += F.G) {
            const int j = u * 64 + F.lane;
            float acc[4] = {0.f, 0.f, 0.f, 0.f};
            const float* wp = a.w_ada + (size_t)(F.wave * 256) * (6 * D) + j;
#pragma unroll 16
            for (int k = 0; k < 256; ++k) { const float w = wp[(size_t)k * (6 * D)]; const int kk = F.wave * 256 + k;
                acc[0] += sc[kk] * w; acc[1] += sc[D + kk] * w; acc[2] += sc[2 * D + kk] * w; acc[3] += sc[3 * D + kk] * w; }
#pragma unroll
            for (int b = 0; b < 4; ++b) part[(F.wave * 4 + b) * 64 + F.lane] = acc[b];
            __syncthreads();
            if (F.wave < 4) { float s = a.b_ada[j];
#pragma unroll
                for (int w = 0; w < 8; ++w) s += part[(w * 4 + F.wave) * 64 + F.lane];
                ada[F.wave * (6 * D) + j] = s; }
            __syncthreads();
        }
    }
    __syncthreads();
    LAS unsigned* scr = (LAS unsigned*)(F.lds + F.wave * 8704);
    const int gw = F.bid * 8 + F.wave, NGW = F.G * 8;
    constexpr int NB_IN = ((FP8GATE ? SRC_ALR + GR : IN_COLS) + 127) / 128;
    constexpr int I_IN = ALR8 ? 0 : 32 * NB_IN, I_PA = FP8PA ? 0 : 16 * 16, I_PG = FP8PG ? 0 : 32 * 16, I_WO = FP8WO ? 0 : 32 * 16;
    constexpr int NITEMS = I_IN + I_PA + I_PG + I_WO;
    for (int it = gw; it < NITEMS; it += NGW) {
        int r = it;
        if (r < I_IN) { if (FP8GATE && 128 * (r / 32) >= C8_LO && 128 * (r / 32 + 1) <= SRC_ALR) continue;
            transpose_item2(a.w_in, D, IN_COLS, (bf16*)(ws + WS_WINT), scr, r % 32, r / 32, F.lane, RmWin()); continue; } r -= I_IN;
        if (r < I_PA) { transpose_item2(a.w_br_att, 1024, D, (bf16*)(ws + WS_PAT), scr, r % 16, r / 16, F.lane, RmIdent()); continue; } r -= I_PA;
        if (r < I_PG) { transpose_item2(a.w_br_gla, D, D, (bf16*)(ws + WS_PGT), scr, r % 32, r / 32, F.lane, RmIdent()); continue; } r -= I_PG;
        transpose_item2(a.w_out, D, D, (bf16*)(ws + WS_WOT), scr, r % 32, r / 32, F.lane, RmIdent());
    }
#if FP8PA
    { constexpr int NIT = 8 * (D / 64);
      for (int it = (gw + NGW - 512) % NGW; it < NIT; it += NGW) { const int kbp = it % 8, nb = it / 8;
#pragma unroll 1
          for (int sub = 0; sub < 2; ++sub) { SubT t; const int kb = 2 * kbp + sub; t.N = D; t.n0 = 64 * nb; t.gu = 0;
              t.src = a.w_br_att + (size_t)(64 * kb) * D + t.n0; t.dst = (bf16*)(ws + WS_PA8 + 64 * kb);
              f32x4 v[16]; subt_load(t, F.lane, v); subt_store8(t, F.lane, v, scr, 1024); } } }
#endif
#if FP8PG
    { constexpr int NIT = 16 * (D / 64);
      for (int it = (gw + NGW - 1024) % NGW; it < NIT; it += NGW) { const int kbp = it % 16, nb = it / 16;
#pragma unroll 1
          for (int sub = 0; sub < 2; ++sub) { SubT t; const int kb = 2 * kbp + sub; t.N = D; t.n0 = 64 * nb; t.gu = 0;
              t.src = a.w_br_gla + (size_t)(64 * kb) * D + t.n0; t.dst = (bf16*)(ws + WS_PG8 + 64 * kb);
              f32x4 v[16]; subt_load(t, F.lane, v); subt_store8(t, F.lane, v, scr); } } }
#endif
#if FP8WO
    { constexpr int NIT = 16 * (D / 64);
      for (int it = NGW - 1 - gw; it < NIT; it += NGW) { const int kbp = it % 16, nb = it / 16;
#pragma unroll 1
          for (int sub = 0; sub < 2; ++sub) { SubT t; const int kb = 2 * kbp + sub; t.N = D; t.n0 = 64 * nb; t.gu = 0;
              t.src = a.w_out + (size_t)(64 * kb) * D + t.n0; t.dst = (bf16*)(ws + WS_WO8 + 64 * kb);
              f32x4 v[16]; subt_load(t, F.lane, v); subt_store8(t, F.lane, v, scr); } } }
#endif
#if FP8GATE
#if ALR8
    { GAS unsigned* z = (GAS unsigned*)(ws + WS_WG8 + (size_t)N8 * D); const int nd = 256 * D / 4;
      for (int i = F.bid * 512 + F.tid; i < nd; i += F.G * 512) { unsigned o = 0u;
          if (i < GR * D / 4) { const int n = i / (D / 4), k = 4 * (i % (D / 4)); const float* wp = a.w_in + (size_t)k * IN_COLS + SRC_ALR + n;
              o = pk4_fp8(64.f * wp[0], 64.f * wp[IN_COLS], 64.f * wp[2 * IN_COLS], 64.f * wp[3 * IN_COLS]); }
          z[i] = o; } }
#else
    { GAS v4u* z = (GAS v4u*)((bf16*)(ws + WS_WINT) + (size_t)(PJ + GR) * D); const int n16 = (NPAD - PJ - GR) * D * 2 / 16;
      for (int i = F.bid * 512 + F.tid; i < n16; i += F.G * 512) z[i] = (v4u){0u, 0u, 0u, 0u}; }
#endif
    { constexpr int NIT = 16 * (N8 / 64);
      for (int it = gw; it < NIT; it += NGW) { const int kbp = it % 16, nb = it / 16;
#pragma unroll 1
          for (int sub = 0; sub < 2; ++sub) { SubT t; const int kb = 2 * kbp + sub; t.N = IN_COLS; t.n0 = 64 * nb; t.gu = 0;
              const int sc0 = C8_LO + t.n0 + (C8_LO + t.n0 >= SRC_ALR ? GR : 0);
              t.src = a.w_in + (size_t)(64 * kb) * IN_COLS + sc0; t.dst = (bf16*)(ws + WS_WG8 + 64 * kb);
              f32x4 v[16]; subt_load(t, F.lane, v); subt_store8(t, F.lane, v, scr); } } }
#else
    { GAS v4u* z = (GAS v4u*)((bf16*)(ws + WS_WINT) + (size_t)(PJ + GR) * D); const int n16 = (NPAD - PJ - GR) * D * 2 / 16;
      for (int i = F.bid * 512 + F.tid; i < n16; i += F.G * 512) z[i] = (v4u){0u, 0u, 0u, 0u}; }
#endif
    __syncthreads();
}
__device__ __forceinline__ void phase_convert_moe(const Frame& F, const Args& a, int ci, int nconv) {
    unsigned char* ws = a.ws;
    LAS unsigned* scr = (LAS unsigned*)(F.lds + F.wave * 8704);
    const int gw = ci * 8 + F.wave, NGW = nconv * 8;
    constexpr int NITEMS = NE * (32 * 64 + 32 * 32);
    const int nsub = (gw < NITEMS / 2) ? 2 * ((NITEMS / 2 - gw + NGW - 1) / NGW) : 0;
#define CQ(j) (((gw + ((j) >> 1) * NGW) << 1) | ((j) & 1))
#if FP8MOE
#define subt_store subt_store8
#endif
    f32x4 ra[16], rb[16], rc[16]; SubT ta, tb, tcx;
    if (nsub > 0) { ta = moe_subtile(a, ws, CQ(0)); subt_load(ta, F.lane, ra); tb = ta; tcx = ta; }
    if (nsub > 1) { tb = moe_subtile(a, ws, CQ(1)); subt_load(tb, F.lane, rb); }
    for (int j = 0; j < nsub; j += 3) {
        if (j + 2 < nsub) { tcx = moe_subtile(a, ws, CQ(j + 2)); subt_load(tcx, F.lane, rc); }
        subt_store(ta, F.lane, ra, scr);
        if (j + 1 < nsub) { if (j + 3 < nsub) { ta = moe_subtile(a, ws, CQ(j + 3)); subt_load(ta, F.lane, ra); }
            subt_store(tb, F.lane, rb, scr); }
        if (j + 2 < nsub) { if (j + 4 < nsub) { tb = moe_subtile(a, ws, CQ(j + 4)); subt_load(tb, F.lane, rb); }
            subt_store(tcx, F.lane, rc, scr); }
    }
#undef CQ
#if FP8MOE
#undef subt_store
#endif
    __syncthreads();
}

#if FP8MOE
__device__ __forceinline__ void conv_issue_stage(const Args& a, unsigned char* ws, int it, int s, LAS unsigned char* slot, int lane) {
    const SubT t = moe_subtile(a, ws, it);
    const float* src = t.src + (size_t)(16 * s + 4 * (lane >> 4)) * t.N + (lane & 15) * 4;
#pragma unroll
    for (int q = 0; q < 4; ++q) __builtin_amdgcn_global_load_lds((const unsigned*)(src + (size_t)q * t.N), (LAS unsigned*)(slot + q * 1024), 16, 0, 2);
}
__device__ __forceinline__ void phase_convert_moe_dma(const Frame& F, const Args& a, int ci, int nconv) {
    unsigned char* ws = a.ws;
    if (F.wave < 4) {
        const int cw = ci * 4 + F.wave, NCW = nconv * 4;
        constexpr int NITEMS = NE * (32 * 64 + 32 * 32);
        const int nitem = (cw < NITEMS / 2) ? 2 * ((NITEMS / 2 - cw + NCW - 1) / NCW) : 0;
#define CQ(j) (((cw + ((j) >> 1) * NCW) << 1) | ((j) & 1))
        LAS unsigned char* ring = F.lds + F.wave * 32768;
        LAS unsigned* scr = (LAS unsigned*)(F.lds + 131072 + F.wave * 4352);
        const int g = F.lane >> 4, n4 = (F.lane & 15) * 4;
        const int nst = nitem * 4;
        for (int st = 0; st < 7 && st < nst; ++st) conv_issue_stage(a, ws, CQ(st >> 2), st & 3, ring + (st & 7) * 4096, F.lane);
        SubT tcur = moe_subtile(a, ws, CQ(0));
        for (int st = 0; st < nst; ++st) {
            const int sidx = st & 3;
            if (st + 7 < nst) { conv_issue_stage(a, ws, CQ((st + 7) >> 2), (st + 7) & 3, ring + ((st + 7) & 7) * 4096, F.lane); asm volatile("s_waitcnt vmcnt(28)" ::: "memory"); }
            else asm volatile("s_waitcnt vmcnt(0)" ::: "memory");
            if (sidx == 0) tcur = moe_subtile(a, ws, CQ(st >> 2));
            const LAS unsigned char* slot = ring + (st & 7) * 4096 + F.lane * 16;
            const f32x4 v0 = *(const LAS f32x4*)slot, v1 = *(const LAS f32x4*)(slot + 1024), v2 = *(const LAS f32x4*)(slot + 2048), v3 = *(const LAS f32x4*)(slot + 3072);
#pragma unroll
            for (int c = 0; c < 4; ++c) scr[(n4 + c) * 17 + 4 * sidx + g] = pk4_fp8(v0[c] * 64.f, v1[c] * 64.f, v2[c] * 64.f, v3[c] * 64.f);
            if (sidx == 3) {
                LDS_WAIT(); asm volatile("" ::: "memory");
#pragma unroll
                for (int j = 0; j < 4; ++j) { const int n = (F.lane >> 2) + 16 * j, q = F.lane & 3, ng = tcur.n0 + n; const LAS unsigned* sp = scr + n * 17 + 4 * q;
                    const v4u o = (v4u){sp[0], sp[1], sp[2], sp[3]};
                    const int row = tcur.gu ? ((ng >> 8) * 256 + (ng & 1) * 128 + ((ng >> 1) & 127)) : ng;
                    *(GAS v4u*)((unsigned char*)tcur.dst + (size_t)row * D + 16 * q) = o; }
                LDS_WAIT(); asm volatile("" ::: "memory");
            }
        }
#undef CQ
    }
    __syncthreads();
}
#endif

__device__ __forceinline__ void load_row(const float* p, int lane, f32x4 (&v)[8]) {
    const GAS f32x4* r = (const GAS f32x4*)p + lane;
#pragma unroll
    for (int j = 0; j < 8; ++j) v[j] = r[64 * j];
}
__device__ __forceinline__ void row_stats(const f32x4 (&v)[8], float& mean, float& rstd) {
    float s = 0.f;
#pragma unroll
    for (int j = 0; j < 8; ++j) s += (v[j].x + v[j].y) + (v[j].z + v[j].w);
    mean = wave_sum(s) * (1.f / D); float s2 = 0.f;
#pragma unroll
    for (int j = 0; j < 8; ++j) { const f32x4 d = v[j] - mean; s2 += (d.x * d.x + d.y * d.y) + (d.z * d.z + d.w * d.w); }
    rstd = 1.f / sqrtf(wave_sum(s2) * (1.f / D) + LN_EPS);
}
__device__ __forceinline__ void phase_lnmod1(const Frame& F, const Args& a) {
    const float* ada = (const float*)(a.ws + WS_ADA); bf16* H = (bf16*)(a.ws + WS_H);
    const int gw = F.bid * 8 + F.wave, NGW = F.G * 8;
    for (int m = gw; m < M; m += NGW) {
        f32x4 v[8]; load_row(a.x + (size_t)m * D, F.lane, v);
        float mean, rstd; row_stats(v, mean, rstd);
        const int b = m / T; const float* sh = ada + b * 6 * D; const float* sc = sh + D;
        GAS v2u* o = (GAS v2u*)(H + (size_t)m * D) + F.lane;
#pragma unroll
        for (int j = 0; j < 8; ++j) { const int c0 = 4 * (F.lane + 64 * j); const f32x4 s = *(const f32x4*)(sc + c0), h = *(const f32x4*)(sh + c0);
            const f32x4 y = (v[j] - mean) * rstd * (s + 1.f) + h; if (!ALR8) { v2u w; w.x = pk2(y.x, y.y); w.y = pk2(y.z, y.w); o[64 * j] = w; }
            if (FP8GATE) ((GAS unsigned*)(a.ws + WS_H8A + (size_t)m * D) + F.lane)[64 * j] = pk4_fp8(y.x, y.y, y.z, y.w); }
    }
}

struct EpiProj {
    bf16* proj; float* alr; bf16* vat; bf16* vgt; bf16* qaf; bf16* kaf; bf16* vaf;
    __device__ __forceinline__ void operator()(const STile&, int row, int col, float v, float) const {
        if (col < PJ) { float y = v; if (col >= C_RG) y = (col < C_GA) ? siluf_(v) : sigmoidf_(v); proj[(size_t)row * PJ + col] = (bf16)f2bf(y);
            const int b = row / T, ts = row % T, qt = ts >> 5, nt = ts & 31;
            if (col < C_KA) { const int hq = col >> 6, d = col & 63; qaf[((((size_t)(b * AH + hq) * (T / 32) + qt) * 4 + (d >> 4)) * 64 + ((d >> 3) & 1) * 32 + nt) * 8 + (d & 7)] = (bf16)f2bf(v); }
            else if (col < C_VA) { const int c = col - C_KA, kh = c >> 6, d = c & 63; kaf[((((size_t)(b * AKV + kh) * (T / 32) + qt) * 4 + (d >> 4)) * 64 + ((d >> 3) & 1) * 32 + nt) * 8 + (d & 7)] = (bf16)f2bf(v); }
            else if (col < C_QG) { const int c = col - C_VA, kh = c >> 6, d = c & 63, s2 = nt >> 4, r16 = nt & 15, jj = 4 * (r16 >> 3) + (r16 & 3), hh = (r16 >> 2) & 1;
                vaf[(((((size_t)(b * AKV + kh) * (T / 32) + qt) * 2 + (d >> 5)) * 2 + s2) * 64 + hh * 32 + (d & 31)) * 8 + jj] = (bf16)f2bf(v);
                vat[((size_t)(b * AKV + kh) * AD + d) * T + ts] = (bf16)f2bf(v); }
            if (col >= C_VG && col < C_RG) { const int c = col - C_VG, t = ts & 63, dv = c % GHV; const int uu = (b * GH + c / GHV) * GNC + (ts >> 6);
                vgt[((((size_t)uu * 16 + (dv >> 5)) * 4 + (t >> 4)) * 64 + ((t >> 3) & 1) * 32 + (dv & 31)) * 8 + (t & 7)] = (bf16)f2bf(v); } }
        else if (col < PJ + GR) alr[(size_t)row * GR + (col - PJ)] = v;
    }
};

__device__ __forceinline__ void phase_attn_simple(const Frame& F, const Args& a) {
    const bf16* proj = (const bf16*)(a.ws + WS_PROJ); bf16* yatt = (bf16*)(a.ws + WS_YATT);
    LAS float* Ks = (LAS float*)F.lds; LAS float* Vs = (LAS float*)(F.lds + 69632);
    for (int u = F.bid; u < NB * (T / 128) * AH; u += F.G) {
        const int b = u / ((T / 128) * AH), rem = u % ((T / 128) * AH), n = rem / AH, hq = rem % AH, kh = hq / 8;
        const int t0 = n * 128;
        __syncthreads();
        { const int j = F.tid >> 1, hf = F.tid & 1; const int s = t0 - 128 + j;
          LAS float* kd = Ks + j * 68 + 32 * hf; LAS float* vd = Vs + j * 68 + 32 * hf;
          if (s >= 0) { const bf16* kp = proj + (size_t)(b * T + s) * PJ + C_KA + kh * 64 + 32 * hf; const bf16* vp = proj + (size_t)(b * T + s) * PJ + C_VA + kh * 64 + 32 * hf;
#pragma unroll
              for (int q = 0; q < 4; ++q) { const v4u kw = *(const GAS v4u*)(kp + 8 * q), vw = *(const GAS v4u*)(vp + 8 * q);
                  *(LAS f32x4*)(kd + 8 * q) = (f32x4){bflo(kw.x), bfhi(kw.x), bflo(kw.y), bfhi(kw.y)}; *(LAS f32x4*)(kd + 8 * q + 4) = (f32x4){bflo(kw.z), bfhi(kw.z), bflo(kw.w), bfhi(kw.w)};
                  *(LAS f32x4*)(vd + 8 * q) = (f32x4){bflo(vw.x), bfhi(vw.x), bflo(vw.y), bfhi(vw.y)}; *(LAS f32x4*)(vd + 8 * q + 4) = (f32x4){bflo(vw.z), bfhi(vw.z), bflo(vw.w), bfhi(vw.w)}; }
          } else {
#pragma unroll
              for (int q = 0; q < 8; ++q) { *(LAS f32x4*)(kd + 4 * q) = (f32x4){0.f, 0.f, 0.f, 0.f}; *(LAS f32x4*)(vd + 4 * q) = (f32x4){0.f, 0.f, 0.f, 0.f}; } }
        }
        __syncthreads();
        const int qi = F.tid >> 2, part = F.tid & 3;
        float q[64];
        { const bf16* qp = proj + (size_t)(b * T + t0 + qi) * PJ + C_QA + hq * 64;
#pragma unroll
          for (int i = 0; i < 8; ++i) { const v4u w = *(const GAS v4u*)(qp + 8 * i);
              q[8 * i + 0] = bflo(w.x) * 0.125f; q[8 * i + 1] = bfhi(w.x) * 0.125f; q[8 * i + 2] = bflo(w.y) * 0.125f; q[8 * i + 3] = bfhi(w.y) * 0.125f;
              q[8 * i + 4] = bflo(w.z) * 0.125f; q[8 * i + 5] = bfhi(w.z) * 0.125f; q[8 * i + 6] = bflo(w.w) * 0.125f; q[8 * i + 7] = bfhi(w.w) * 0.125f; } }
        const float slope = exp2f(-0.5f * (float)(hq + 1)), sink = a.sinks[hq];
        float mloc = -INFINITY;
#pragma unroll 1
        for (int jj = 0; jj < 32; ++jj) {
            const int w = 32 * part + jj, row = qi + 1 + w; const bool ok = (n > 0) || (row >= 128);
            const LAS float* kr = Ks + row * 68; float d0 = 0.f, d1 = 0.f;
#pragma unroll
            for (int i = 0; i < 16; ++i) { const f32x4 kv = *(const LAS f32x4*)(kr + 4 * i); d0 += q[4 * i] * kv.x + q[4 * i + 1] * kv.y; d1 += q[4 * i + 2] * kv.z + q[4 * i + 3] * kv.w; }
            const float s = ok ? (d0 + d1) - slope * (float)(127 - w) : -INFINITY; mloc = fmaxf(mloc, s);
        }
        mloc = fmaxf(mloc, __shfl_xor(mloc, 1)); mloc = fmaxf(mloc, __shfl_xor(mloc, 2));
        const float mx = fmaxf(mloc, sink);
        float o[64]; float l = 0.f;
#pragma unroll
        for (int i = 0; i < 64; ++i) o[i] = 0.f;
#pragma unroll 1
        for (int jj = 0; jj < 32; ++jj) {
            const int w = 32 * part + jj, row = qi + 1 + w; const bool ok = (n > 0) || (row >= 128);
            const LAS float* kr = Ks + row * 68; float d0 = 0.f, d1 = 0.f;
#pragma unroll
            for (int i = 0; i < 16; ++i) { const f32x4 kv = *(const LAS f32x4*)(kr + 4 * i); d0 += q[4 * i] * kv.x + q[4 * i + 1] * kv.y; d1 += q[4 * i + 2] * kv.z + q[4 * i + 3] * kv.w; }
            const float s = ok ? (d0 + d1) - slope * (float)(127 - w) : -INFINITY;
            const float p = __expf(s - mx); l += p;
            const LAS float* vr = Vs + row * 68;
#pragma unroll
            for (int i = 0; i < 16; ++i) { const f32x4 vv = *(const LAS f32x4*)(vr + 4 * i); o[4 * i] += p * vv.x; o[4 * i + 1] += p * vv.y; o[4 * i + 2] += p * vv.z; o[4 * i + 3] += p * vv.w; }
        }
        l += __shfl_xor(l, 1); l += __shfl_xor(l, 2);
#pragma unroll
        for (int i = 0; i < 64; ++i) { o[i] += __shfl_xor(o[i], 1); o[i] += __shfl_xor(o[i], 2); }
        const float inv = 1.f / (l + __expf(sink - mx));
        bf16* op = yatt + (size_t)(b * T + t0 + qi) * (AH * AD) + hq * 64;
#pragma unroll
        for (int pp = 0; pp < 4; ++pp) if (part == pp) {
            v4u w0, w1;
            w0.x = pk2(o[16 * pp + 0] * inv, o[16 * pp + 1] * inv); w0.y = pk2(o[16 * pp + 2] * inv, o[16 * pp + 3] * inv); w0.z = pk2(o[16 * pp + 4] * inv, o[16 * pp + 5] * inv); w0.w = pk2(o[16 * pp + 6] * inv, o[16 * pp + 7] * inv);
            w1.x = pk2(o[16 * pp + 8] * inv, o[16 * pp + 9] * inv); w1.y = pk2(o[16 * pp + 10] * inv, o[16 * pp + 11] * inv); w1.z = pk2(o[16 * pp + 12] * inv, o[16 * pp + 13] * inv); w1.w = pk2(o[16 * pp + 14] * inv, o[16 * pp + 15] * inv);
            *(GAS v4u*)(op + 16 * pp) = w0; *(GAS v4u*)(op + 16 * pp + 8) = w1; }
    }
    __syncthreads();
}

typedef float f32x16 __attribute__((ext_vector_type(16)));
__device__ __forceinline__ void phase_attn_mfma(const Frame& F, const Args& a) {
    const bf16* qaf = (const bf16*)(a.ws + WS_QAF); const bf16* kaf = (const bf16*)(a.ws + WS_KAF); const bf16* vaf = (const bf16*)(a.ws + WS_VAF); bf16* yatt = (bf16*)(a.ws + WS_YATT);
    const int n = F.lane & 31, h = F.lane >> 5;
    for (int u = F.bid; u < (M / 32) * AKV; u += F.G) {
        const int kh = u & 1, qt = u >> 1, b = qt / (T / 32), qtl = qt % (T / 32), tq0 = qtl * 32, hq = kh * 8 + F.wave;
        const float slope = exp2f(-0.5f * (float)(hq + 1)), sink = a.sinks[hq];
        bf16x8 bq[4];
        { const bf16* qp = qaf + ((((size_t)(b * AH + hq) * (T / 32) + qtl) * 4) * 64 + F.lane) * 8;
#pragma unroll
          for (int s = 0; s < 4; ++s) bq[s] = *(const GAS bf16x8*)(qp + 512 * s); }
        f32x16 st[5];
#pragma unroll
        for (int kt = 0; kt < 5; ++kt) {
            const int ktl = qtl - 4 + kt;
#pragma unroll
            for (int r = 0; r < 16; ++r) st[kt][r] = 0.f;
            if (ktl >= 0) {
                const bf16* kp = kaf + ((((size_t)(b * AKV + kh) * (T / 32) + ktl) * 4) * 64 + F.lane) * 8;
                bf16x8 ak[4];
#pragma unroll
                for (int s = 0; s < 4; ++s) ak[s] = *(const GAS bf16x8*)(kp + 512 * s);
#pragma unroll
                for (int s = 0; s < 4; ++s) st[kt] = __builtin_amdgcn_mfma_f32_32x32x16_bf16(ak[s], bq[s], st[kt], 0, 0, 0);
            }
        }
        bf16x8 av[5][2][2];
#pragma unroll
        for (int kt = 0; kt < 5; ++kt) { const int ktl = qtl - 4 + kt; const int ktc = ktl >= 0 ? ktl : 0;
            const bf16* vp = vaf + ((((size_t)(b * AKV + kh) * (T / 32) + ktc) * 4) * 64 + F.lane) * 8;
#pragma unroll
            for (int dt = 0; dt < 2; ++dt)
#pragma unroll
                for (int s2 = 0; s2 < 2; ++s2) av[kt][dt][s2] = *(const GAS bf16x8*)(vp + 1024 * dt + 512 * s2); }
        const int t = tq0 + n; const int lb = n - 4 * h; const float fb = -slope * (float)lb; float mloc = -INFINITY;
#pragma unroll
        for (int kt = 0; kt < 5; ++kt) { const bool live = (qtl - 4 + kt) >= 0;
#pragma unroll
            for (int r = 0; r < 16; ++r) { const int C = 128 - 32 * kt - ((r & 3) + 8 * (r >> 2));
                float v = fmaf(-slope, (float)C, fmaf(st[kt][r], 0.125f, fb));
                if (kt == 0) v = (lb + C < WIN) ? v : -INFINITY;
                if (kt == 4) v = (lb + C >= 0) ? v : -INFINITY;
                if (!live) v = -INFINITY;
                st[kt][r] = v; mloc = fmaxf(mloc, v); } }
        mloc = fmaxf(mloc, __shfl_xor(mloc, 32));
        const float mx = fmaxf(mloc, sink); float l = 0.f;
        const float mxl = mx * 1.4426950408889634f;
#pragma unroll
        for (int kt = 0; kt < 5; ++kt)
#pragma unroll
            for (int r = 0; r < 16; ++r) { const float p = __builtin_amdgcn_exp2f(fmaf(st[kt][r], 1.4426950408889634f, -mxl)); st[kt][r] = p; l += p; }
        l += __shfl_xor(l, 32);
        const float inv = __builtin_amdgcn_rcpf(l + __expf(sink - mx));
        f32x16 o0, o1;
#pragma unroll
        for (int r = 0; r < 16; ++r) { o0[r] = 0.f; o1[r] = 0.f; }
#pragma unroll
        for (int kt = 0; kt < 5; ++kt) {
            if ((qtl - 4 + kt) >= 0) {
#pragma unroll
                for (int s2 = 0; s2 < 2; ++s2) {
                    v4u pw; pw.x = pk2(st[kt][8 * s2 + 0], st[kt][8 * s2 + 1]); pw.y = pk2(st[kt][8 * s2 + 2], st[kt][8 * s2 + 3]); pw.z = pk2(st[kt][8 * s2 + 4], st[kt][8 * s2 + 5]); pw.w = pk2(st[kt][8 * s2 + 6], st[kt][8 * s2 + 7]);
                    const bf16x8 pb = __builtin_bit_cast(bf16x8, pw);
                    o0 = __builtin_amdgcn_mfma_f32_32x32x16_bf16(av[kt][0][s2], pb, o0, 0, 0, 0);
                    o1 = __builtin_amdgcn_mfma_f32_32x32x16_bf16(av[kt][1][s2], pb, o1, 0, 0, 0);
                }
            }
        }
        bf16* op = yatt + (size_t)(b * T + t) * (AH * AD) + hq * 64 + 4 * h;
#pragma unroll
        for (int g = 0; g < 4; ++g) {
#if FP8PA
            GAS unsigned char* o8 = (GAS unsigned char*)yatt + (size_t)(b * T + t) * (AH * AD) + hq * 64 + 4 * h + 8 * g; const float i16 = 16.f * inv;
            *(GAS unsigned*)o8 = pk4_fp8(o0[4 * g] * i16, o0[4 * g + 1] * i16, o0[4 * g + 2] * i16, o0[4 * g + 3] * i16);
            *(GAS unsigned*)(o8 + 32) = pk4_fp8(o1[4 * g] * i16, o1[4 * g + 1] * i16, o1[4 * g + 2] * i16, o1[4 * g + 3] * i16); }
#else
            v2u w0, w1; w0.x = pk2(o0[4 * g] * inv, o0[4 * g + 1] * inv); w0.y = pk2(o0[4 * g + 2] * inv, o0[4 * g + 3] * inv);
            w1.x = pk2(o1[4 * g] * inv, o1[4 * g + 1] * inv); w1.y = pk2(o1[4 * g + 2] * inv, o1[4 * g + 3] * inv);
            *(GAS v2u*)(op + 8 * g) = w0; *(GAS v2u*)(op + 32 + 8 * g) = w1; }
#endif
    }
}

__device__ __forceinline__ float logsig16(float z) { return (fminf(z, 0.f) - __logf(1.f + __expf(-fabsf(z)))) * (1.f / 16.f); }
__device__ __forceinline__ void phase_gla_prep_mfma(const Frame& F, const Args& a) {
    const bf16* proj = (const bf16*)(a.ws + WS_PROJ); const float* alr = (const float*)(a.ws + WS_ALR);
    bf16* QEF = (bf16*)(a.ws + WS_QEF); bf16* KEF = (bf16*)(a.ws + WS_KEF); bf16* AMF = (bf16*)(a.ws + WS_AMF); float* DL = (float*)(a.ws + WS_DLAST);
    LAS float* Al = (LAS float*)F.lds;
    LAS float* Tot = (LAS float*)(F.lds + 4096);
    LAS bf16* Qs = (LAS bf16*)(F.lds + 8192);
    LAS bf16* Ks = (LAS bf16*)(F.lds + 8192 + 33792);
    LAS bf16* KT = (LAS bf16*)(F.lds + 8192 + 2 * 33792);
    for (int u = F.bid; u < NB * GH * GNC; u += F.G) {
        const int bh = u / GNC, n = u % GNC, b = bh / GH, hd = bh % GH; const int m0 = b * T + n * GC;
        __syncthreads();
        for (int i = F.tid; i < GC * GR; i += 512) Al[i] = alr[(size_t)m0 * GR + i];
        __syncthreads();
        const int ch = F.tid & 255, th = F.tid >> 8, col = hd * GHK + ch;
        float wu[GR];
#pragma unroll
        for (int r = 0; r < GR; ++r) wu[r] = a.w_gla_up[r * GDK + col];
        const float bg = a.b_gla_gate[col];
        unsigned short qr[32], kr[32];
        { const bf16* qp = proj + (size_t)(m0 + th * 32) * PJ + C_QG + col;
#pragma unroll
          for (int tt = 0; tt < 32; ++tt) { qr[tt] = qp[(size_t)tt * PJ]; kr[tt] = qp[(size_t)tt * PJ + (C_KG - C_QG)]; } }
        float la[32]; float run = 0.f;
#pragma unroll
        for (int tt = 0; tt < 32; ++tt) { const int t = th * 32 + tt; float z = bg;
#pragma unroll
            for (int r = 0; r < GR; r += 4) { const f32x4 av = *(const LAS f32x4*)(Al + t * GR + r); z += av.x * wu[r] + av.y * wu[r + 1] + av.z * wu[r + 2] + av.w * wu[r + 3]; }
            la[tt] = logsig16(z); run += la[tt]; }
        Tot[th * 256 + ch] = run;
        __syncthreads();
        const float tot0 = Tot[ch], blast = tot0 + Tot[256 + ch];
        float cum = th ? tot0 : 0.f;
#pragma unroll
        for (int tt = 0; tt < 32; ++tt) { const int t = th * 32 + tt;
            cum += la[tt];
            const float qv = bf2f(qr[tt]), kv = bf2f(kr[tt]);
            const float e1 = __expf(cum);
            Qs[t * 264 + ch] = (bf16)f2bf(qv * (1.f / 16.f) * e1); Ks[t * 264 + ch] = (bf16)f2bf(kv * __expf(-cum)); KT[ch * 66 + t] = (bf16)f2bf(kv * __expf(blast - cum)); }
        if (th == 1) DL[(size_t)u * GHK + ch] = __expf(blast);
        __syncthreads();
        { const int ti = F.wave >> 1, fr = F.lane & 15, kg = F.lane >> 4;
#pragma unroll
          for (int tjj = 0; tjj < 2; ++tjj) { const int tj = 2 * (F.wave & 1) + tjj; f32x4 acc = (f32x4){0.f, 0.f, 0.f, 0.f};
#pragma unroll
              for (int s = 0; s < 8; ++s) { const bf16x8 af = *(const LAS bf16x8*)(Qs + (16 * ti + fr) * 264 + 32 * s + 8 * kg), bf_ = *(const LAS bf16x8*)(Ks + (16 * tj + fr) * 264 + 32 * s + 8 * kg);
                  acc = __builtin_amdgcn_mfma_f32_16x16x32_bf16(af, bf_, acc, 0, 0, 0); }
#pragma unroll
              for (int r = 0; r < 4; ++r) { const int i = 16 * ti + 4 * kg + r, j = 16 * tj + fr;
                  AMF[((((size_t)u * 2 + (i >> 5)) * 4 + (j >> 4)) * 64 + ((j >> 3) & 1) * 32 + (i & 31)) * 8 + (j & 7)] = (bf16)f2bf(j <= i ? acc[r] : 0.f); } } }
#pragma unroll
        for (int k = 0; k < 4; ++k) { const int pidx = F.tid + 512 * k, ln = pidx & 63, s = (pidx >> 6) & 1, tt = (pidx >> 7) & 1, w = pidx >> 8, n_ = ln & 31, h = ln >> 5;
            const LAS v2u* src = (const LAS v2u*)(Qs + (32 * tt + n_) * 264 + 32 * w + 16 * s + 4 * h); const v2u lo = src[0], hi = src[2];
            *(GAS v4u*)(QEF + ((size_t)u * 2048 + pidx) * 8) = (v4u){lo.x, lo.y, hi.x, hi.y}; }
#pragma unroll
        for (int k = 0; k < 4; ++k) { const int pidx = F.tid + 512 * k, ln = pidx & 63, s = (pidx >> 6) & 3, w = pidx >> 8, n_ = ln & 31, h = ln >> 5;
            const LAS unsigned* src = (const LAS unsigned*)(KT + (32 * w + n_) * 66 + 16 * s + 8 * h);
            *(GAS v4u*)(KEF + ((size_t)u * 2048 + pidx) * 8) = (v4u){src[0], src[1], src[2], src[3]}; }
    }
    __syncthreads();
}
__device__ __forceinline__ bf16x8 ld_perm8(const bf16* p) { const v2u lo = *(const GAS v2u*)p, hi = *(const GAS v2u*)(p + 8); return __builtin_bit_cast(bf16x8, (v4u){lo.x, lo.y, hi.x, hi.y}); }
struct ScanE { bf16x8 q00, q01, q10, q11, am, vj; };
struct ScanL { bf16x8 kf[4], vf[4]; f32x4 d4[4]; };
__device__ __forceinline__ void scan_load_e(ScanE& o, const bf16* QEF, const bf16* VGF, const bf16* AMF, int u, int sl, int w, int lane, int ttw, int js) {
    const bf16* qb = QEF + (((size_t)u * 8 + w) * 4 * 64 + lane) * 8;
    o.q00 = *(const GAS bf16x8*)qb; o.q01 = *(const GAS bf16x8*)(qb + 512); o.q10 = *(const GAS bf16x8*)(qb + 1024); o.q11 = *(const GAS bf16x8*)(qb + 1536);
    o.am = *(const GAS bf16x8*)(AMF + ((((size_t)u * 2 + ttw) * 4 + js) * 64 + lane) * 8);
    o.vj = *(const GAS bf16x8*)(VGF + ((((size_t)u * 16 + sl) * 4 + js) * 64 + lane) * 8);
}
__device__ __forceinline__ void scan_load_l(ScanL& o, const bf16* KEF, const bf16* VGF, const float* DL, int u, int sl, int w, int lane, int h) {
    const bf16* kb = KEF + (((size_t)u * 8 + w) * 4 * 64 + lane) * 8; const bf16* vb = VGF + (((size_t)u * 16 + sl) * 4 * 64 + lane) * 8;
#pragma unroll
    for (int s = 0; s < 4; ++s) { o.kf[s] = *(const GAS bf16x8*)(kb + 512 * s); o.vf[s] = *(const GAS bf16x8*)(vb + 512 * s); }
#pragma unroll
    for (int g = 0; g < 4; ++g) o.d4[g] = *(const GAS f32x4*)(DL + (size_t)u * GHK + 32 * w + 8 * g + 4 * h);
}
__device__ __forceinline__ void phase_gla_scan_mfma(const Frame& F, const Args& a) {
    const bf16* QE = (const bf16*)(a.ws + WS_QEF); const bf16* KENDT = (const bf16*)(a.ws + WS_KEF); const bf16* VGT = (const bf16*)(a.ws + WS_VGT);
    const bf16* AM = (const bf16*)(a.ws + WS_AMF); const float* DL = (const float*)(a.ws + WS_DLAST); bf16* OG = (bf16*)(a.ws + WS_OG);
    LAS float* P = (LAS float*)F.lds;
    const int n_ = F.lane & 31, h = F.lane >> 5, w = F.wave, ttw = w >> 2, js = w & 3;
    const int vcu = (F.G % 8 == 0) ? (F.bid % 8) * (F.G / 8) + F.bid / 8 : F.bid;
    for (int item = vcu; item < NB * GH * 16; item += F.G) {
        const int bh = item >> 4, sl = item & 15, b = bh / GH, hd = bh % GH;
        f32x16 S;
#pragma unroll
        for (int r = 0; r < 16; ++r) S[r] = 0.f;
        __syncthreads();
        ScanE e0, e1; ScanL l0;
        scan_load_e(e0, QE, VGT, AM, bh * GNC, sl, w, F.lane, ttw, js); scan_load_l(l0, KENDT, VGT, DL, bh * GNC, sl, w, F.lane, h);
        scan_load_e(e1, QE, VGT, AM, bh * GNC + 1, sl, w, F.lane, ttw, js);
        for (int n = 0; n < GNC; ++n) {
            const int m0 = b * T + n * GC;
            const int n2 = (n + 2 < GNC) ? n + 2 : GNC - 1, n1 = (n + 1 < GNC) ? n + 1 : GNC - 1;
            ScanE e2; scan_load_e(e2, QE, VGT, AM, bh * GNC + n2, sl, w, F.lane, ttw, js);
            ScanL l1; scan_load_l(l1, KENDT, VGT, DL, bh * GNC + n1, sl, w, F.lane, h);
            v4u s0, s1; s0.x = pk2(S[0], S[1]); s0.y = pk2(S[2], S[3]); s0.z = pk2(S[4], S[5]); s0.w = pk2(S[6], S[7]); s1.x = pk2(S[8], S[9]); s1.y = pk2(S[10], S[11]); s1.z = pk2(S[12], S[13]); s1.w = pk2(S[14], S[15]);
            const bf16x8 sb0 = __builtin_bit_cast(bf16x8, s0), sb1 = __builtin_bit_cast(bf16x8, s1);
            f32x16 po0, po1;
#pragma unroll
            for (int r = 0; r < 16; ++r) { po0[r] = 0.f; po1[r] = 0.f; }
            po0 = __builtin_amdgcn_mfma_f32_32x32x16_bf16(e0.q00, sb0, po0, 0, 0, 0); po0 = __builtin_amdgcn_mfma_f32_32x32x16_bf16(e0.q01, sb1, po0, 0, 0, 0);
            po1 = __builtin_amdgcn_mfma_f32_32x32x16_bf16(e0.q10, sb0, po1, 0, 0, 0); po1 = __builtin_amdgcn_mfma_f32_32x32x16_bf16(e0.q11, sb1, po1, 0, 0, 0);
            if (ttw == 0) po0 = __builtin_amdgcn_mfma_f32_32x32x16_bf16(e0.am, e0.vj, po0, 0, 0, 0); else po1 = __builtin_amdgcn_mfma_f32_32x32x16_bf16(e0.am, e0.vj, po1, 0, 0, 0);
            LAS float* Pb = P + (n & 1) * 16384;
#pragma unroll
            for (int r = 0; r < 16; ++r) { Pb[((w * 2 + 0) * 16 + r) * 64 + F.lane] = po0[r]; Pb[((w * 2 + 1) * 16 + r) * 64 + F.lane] = po1[r]; }
#pragma unroll
            for (int r = 0; r < 16; ++r) S[r] *= l0.d4[r >> 2][r & 3];
#pragma unroll
            for (int s = 0; s < 4; ++s) S = __builtin_amdgcn_mfma_f32_32x32x16_bf16(l0.kf[s], l0.vf[s], S, 0, 0, 0);
            asm volatile("s_waitcnt lgkmcnt(0)" ::: "memory"); __builtin_amdgcn_s_barrier(); asm volatile("" ::: "memory");
            { const int tt = w >> 2, g = w & 3;
#pragma unroll
              for (int i = 0; i < 4; ++i) { const int r = 4 * g + i; float sum = 0.f;
#pragma unroll
                  for (int w2 = 0; w2 < 8; ++w2) sum += Pb[((w2 * 2 + tt) * 16 + r) * 64 + F.lane];
                  OG[(size_t)(m0 + 32 * tt + 8 * g + 4 * h + i) * GDV + hd * GHV + sl * 32 + n_] = (bf16)f2bf(sum); } }
            e0 = e1; e1 = e2; l0 = l1;
        }
    }
    __syncthreads();
}

__device__ __forceinline__ void phase_gla_prep_simple(const Frame& F, const Args& a) {
    const bf16* proj = (const bf16*)(a.ws + WS_PROJ); const float* alr = (const float*)(a.ws + WS_ALR);
    bf16* QE = (bf16*)(a.ws + WS_QE); bf16* KEND = (bf16*)(a.ws + WS_KEND); bf16* AM = (bf16*)(a.ws + WS_AMAT); float* DL = (float*)(a.ws + WS_DLAST);
    LAS float* Bq = (LAS float*)F.lds; LAS float* Ke = (LAS float*)(F.lds + 65536); LAS float* Al = (LAS float*)(F.lds + 131072); LAS float* Bl = (LAS float*)(F.lds + 131072 + 4096);
    for (int u = F.bid; u < NB * GH * GNC; u += F.G) {
        const int bh = u / GNC, n = u % GNC, b = bh / GH, h = bh % GH; const int m0 = b * T + n * GC;
        __syncthreads();
        for (int i = F.tid; i < GC * GR; i += 512) Al[i] = alr[(size_t)m0 * GR + i];
        __syncthreads();
        if (F.tid < GHK) {
            const int col = h * GHK + F.tid; float wu[GR];
#pragma unroll
            for (int r = 0; r < GR; ++r) wu[r] = a.w_gla_up[r * GDK + col];
            const float bg = a.b_gla_gate[col]; float run = 0.f;
            for (int t = 0; t < GC; ++t) { float z = bg;
#pragma unroll
                for (int r = 0; r < GR; ++r) z += Al[t * GR + r] * wu[r];
                const float ls = fminf(z, 0.f) - log1pf(__expf(-fabsf(z))); run += ls * (1.f / 16.f); Bq[t * GHK + F.tid] = run; }
            Bl[F.tid] = run; DL[(size_t)u * GHK + F.tid] = __expf(run);
        }
        __syncthreads();
#pragma unroll 4
        for (int k = 0; k < 32; ++k) { const int idx = F.tid + 512 * k, t = idx >> 8, i = idx & 255;
            const float bb = Bq[idx], bl = Bl[i];
            const float qv = bf2f(proj[(size_t)(m0 + t) * PJ + C_QG + h * GHK + i]), kv = bf2f(proj[(size_t)(m0 + t) * PJ + C_KG + h * GHK + i]);
            const float qe = qv * (1.f / 16.f) * __expf(bb), ke = kv * __expf(-bb), kend = kv * __expf(bl - bb);
            Bq[idx] = qe; Ke[idx] = ke; QE[(size_t)(m0 + t) * GDK + h * GHK + i] = (bf16)f2bf(qe); KEND[(size_t)(m0 + t) * GDK + h * GHK + i] = (bf16)f2bf(kend); }
        __syncthreads();
        { const int i = F.tid >> 3, j0 = (F.tid & 7) * 8; float acc[8];
#pragma unroll
          for (int e = 0; e < 8; ++e) acc[e] = 0.f;
          for (int d = 0; d < GHK; d += 4) { const f32x4 qv = *(const LAS f32x4*)(Bq + i * GHK + d);
#pragma unroll
              for (int e = 0; e < 8; ++e) { const f32x4 kv = *(const LAS f32x4*)(Ke + (j0 + e) * GHK + d); acc[e] += (qv.x * kv.x + qv.y * kv.y) + (qv.z * kv.z + qv.w * kv.w); } }
          v4u w; w.x = pk2(j0 + 0 <= i ? acc[0] : 0.f, j0 + 1 <= i ? acc[1] : 0.f); w.y = pk2(j0 + 2 <= i ? acc[2] : 0.f, j0 + 3 <= i ? acc[3] : 0.f);
          w.z = pk2(j0 + 4 <= i ? acc[4] : 0.f, j0 + 5 <= i ? acc[5] : 0.f); w.w = pk2(j0 + 6 <= i ? acc[6] : 0.f, j0 + 7 <= i ? acc[7] : 0.f);
          *(GAS v4u*)(AM + (size_t)u * GC * GC + i * GC + j0) = w; }
    }
    __syncthreads();
}

__device__ __forceinline__ void phase_gla_scan_simple(const Frame& F, const Args& a) {
    const bf16* proj = (const bf16*)(a.ws + WS_PROJ); const bf16* QE = (const bf16*)(a.ws + WS_QE); const bf16* KEND = (const bf16*)(a.ws + WS_KEND);
    const bf16* AM = (const bf16*)(a.ws + WS_AMAT); const float* DL = (const float*)(a.ws + WS_DLAST); bf16* OG = (bf16*)(a.ws + WS_OG);
    LAS float* S = (LAS float*)F.lds;
    LAS bf16* Qs = (LAS bf16*)(F.lds + 32768);
    LAS bf16* Kx = (LAS bf16*)(F.lds + 65536);
    LAS float* Vs = (LAS float*)(F.lds + 98304);
    LAS float* As = (LAS float*)(F.lds + 106496);
    LAS float* Ds = (LAS float*)(F.lds + 122880);
    for (int w = F.bid; w < NB * GH * 16; w += F.G) {
        const int bh = w >> 4, sl = w & 15, b = bh / GH, h = bh % GH;
        __syncthreads();
        for (int i = F.tid; i < GHK * 32; i += 512) S[i] = 0.f;
        for (int n = 0; n < GNC; ++n) {
            const int m0 = b * T + n * GC, u = bh * GNC + n;
            __syncthreads();
#pragma unroll
            for (int k = 0; k < 4; ++k) { const int idx = F.tid + 512 * k, t = idx >> 5, c = idx & 31;
                *(LAS v4u*)(Qs + t * GHK + 8 * c) = *(const GAS v4u*)(QE + (size_t)(m0 + t) * GDK + h * GHK + 8 * c);
                *(LAS v4u*)(Kx + t * GHK + 8 * c) = *(const GAS v4u*)(KEND + (size_t)(m0 + t) * GDK + h * GHK + 8 * c); }
#pragma unroll
            for (int k = 0; k < 4; ++k) { const int idx = F.tid + 512 * k, t = idx >> 5, c = idx & 31; Vs[idx] = bf2f(proj[(size_t)(m0 + t) * PJ + C_VG + h * GHV + sl * 32 + c]); }
#pragma unroll
            for (int k = 0; k < 8; ++k) { const int idx = F.tid + 512 * k; As[idx] = bf2f(AM[(size_t)u * GC * GC + idx]); }
            if (F.tid < GHK) Ds[F.tid] = DL[(size_t)u * GHK + F.tid];
            __syncthreads();
            { const int t = F.tid >> 3, dq = F.tid & 7; f32x4 o = (f32x4){0.f, 0.f, 0.f, 0.f};
              for (int j = 0; j < GC; ++j) { const float av = As[t * GC + j]; o += *(const LAS f32x4*)(Vs + j * 32 + 4 * dq) * av; }
              for (int dk = 0; dk < GHK; ++dk) { const float qv = bf2f(Qs[t * GHK + dk]); o += *(const LAS f32x4*)(S + dk * 32 + 4 * dq) * qv; }
              { v2u w_; w_.x = pk2(o.x, o.y); w_.y = pk2(o.z, o.w); *(GAS v2u*)(OG + (size_t)(m0 + t) * GDV + h * GHV + sl * 32 + 4 * dq) = w_; } }
            __syncthreads();
            { const int dk = F.tid >> 1, hv = F.tid & 1; const float dd = Ds[dk]; f32x4 s[4];
#pragma unroll
              for (int i = 0; i < 4; ++i) s[i] = *(const LAS f32x4*)(S + dk * 32 + 16 * hv + 4 * i) * dd;
              for (int j = 0; j < GC; ++j) { const float kv = bf2f(Kx[j * GHK + dk]);
#pragma unroll
                  for (int i = 0; i < 4; ++i) s[i] += *(const LAS f32x4*)(Vs + j * 32 + 16 * hv + 4 * i) * kv; }
#pragma unroll
              for (int i = 0; i < 4; ++i) *(LAS f32x4*)(S + dk * 32 + 16 * hv + 4 * i) = s[i]; }
        }
    }
    __syncthreads();
}

struct EpiT1 { const bf16* proj; bf16* t1;
    __device__ __forceinline__ void operator()(const STile&, int row, int col, float v, float) const { t1[(size_t)row * D + col] = (bf16)f2bf(v * bf2f(proj[(size_t)row * PJ + C_GA + col])); } };
__device__ __forceinline__ void phase_gla_finish(const Frame& F, const Args& a) {
    const bf16* OG = (const bf16*)(a.ws + WS_OG); const bf16* proj = (const bf16*)(a.ws + WS_PROJ); bf16* Y = (bf16*)(a.ws + WS_YGLA);
    const int gw = F.bid * 8 + F.wave, NGW = F.G * 8;
    for (int m = gw; m < M; m += NGW) {
        f32x4 v[8]; { const GAS v2u* op = (const GAS v2u*)(OG + (size_t)m * GDV) + F.lane;
#pragma unroll
            for (int j = 0; j < 8; ++j) { const v2u r = op[64 * j]; v[j] = (f32x4){bflo(r.x), bfhi(r.x), bflo(r.y), bfhi(r.y)}; } }
        float rs[4];
#pragma unroll
        for (int h = 0; h < 4; ++h) { float s = 0.f;
#pragma unroll
            for (int j = 2 * h; j < 2 * h + 2; ++j) s += (v[j].x * v[j].x + v[j].y * v[j].y) + (v[j].z * v[j].z + v[j].w * v[j].w);
            rs[h] = 1.f / sqrtf(wave_sum(s) * (1.f / GHV) + LN_EPS); }
        GAS v2u* o = (GAS v2u*)(Y + (size_t)m * GDV) + F.lane; const GAS v2u* rg = (const GAS v2u*)(proj + (size_t)m * PJ + C_RG) + F.lane;
#pragma unroll
        for (int j = 0; j < 8; ++j) { const int c0 = 4 * (F.lane + 64 * j); const f32x4 g = *(const f32x4*)(a.gla_gain + c0); const v2u r = rg[64 * j];
            const f32x4 y = v[j] * rs[j >> 1] * g * (f32x4){bflo(r.x), bfhi(r.x), bflo(r.y), bfhi(r.y)};
#if FP8PG
            ((GAS unsigned*)((unsigned char*)Y + (size_t)m * GDV) + F.lane)[64 * j] = pk4_fp8(8.f * y.x, 8.f * y.y, 8.f * y.z, 8.f * y.w); }
#else
            v2u w; w.x = pk2(y.x, y.y); w.y = pk2(y.z, y.w); o[64 * j] = w; }
#endif
    }
}
struct EpiMerged { const bf16* proj; const bf16* t1; bf16* mg;
    __device__ __forceinline__ void operator()(const STile&, int row, int col, float v, float) const { mg[(size_t)row * D + col] = (bf16)f2bf(bf2f(t1[(size_t)row * D + col]) + v * bf2f(proj[(size_t)row * PJ + C_GG + col])); } };
struct EpiU { const float* x; const float* ada; bf16* u;
    __device__ __forceinline__ void operator()(const STile&, int row, int col, float v, float) const { const int b = row / T; u[(size_t)row * D + col] = (bf16)f2bf(ada[b * 6 * D + 2 * D + col] * v); } };

__device__ __forceinline__ void phase_ln_router(const Frame& F, const Args& a) {
    const float* U = (const float*)(a.ws + WS_U); float* X1 = (float*)(a.ws + WS_X1); bf16* H = (bf16*)(a.ws + WS_H); const float* ada = (const float*)(a.ws + WS_ADA);
    int* TOPE = (int*)(a.ws + WS_TOPE); float* TOPW = (float*)(a.ws + WS_TOPW); int* HIST = (int*)(a.ws + WS_HIST);
    LAS float* hs = (LAS float*)(F.lds + F.wave * 8192);
    LAS int* cnt = (LAS int*)(F.lds + 65536);
    for (int vb = F.bid; vb < 256; vb += F.G) {
        __syncthreads();
        if (F.tid < NE) cnt[F.tid] = 0;
        __syncthreads();
        for (int rr = 0; rr < 8; ++rr) {
            const int m = vb * 64 + F.wave * 8 + rr, b = m / T;
            f32x4 v[8]; load_row(U + (size_t)m * D, F.lane, v);
            float mean, rstd; row_stats(v, mean, rstd);
            GAS f32x4* xo = (GAS f32x4*)(X1 + (size_t)m * D) + F.lane;
#pragma unroll
            for (int j = 0; j < 8; ++j) { const int c0 = 4 * (F.lane + 64 * j); v[j] = (v[j] - mean) * rstd * *(const f32x4*)(a.ln1_g + c0) + *(const f32x4*)(a.ln1_b + c0); xo[64 * j] = v[j]; }
            row_stats(v, mean, rstd);
            const float* sh = ada + b * 6 * D + 3 * D; const float* sc = sh + D;
            GAS v2u* ho = (GAS v2u*)(H + (size_t)m * D) + F.lane;
#pragma unroll
            for (int j = 0; j < 8; ++j) { const int c0 = 4 * (F.lane + 64 * j); const f32x4 y = (v[j] - mean) * rstd * (*(const f32x4*)(sc + c0) + 1.f) + *(const f32x4*)(sh + c0);
                v2u w; w.x = pk2(y.x, y.y); w.y = pk2(y.z, y.w); ho[64 * j] = w; *(LAS f32x4*)(hs + c0) = y; }
            LDS_WAIT(); asm volatile("" ::: "memory");
            const int e = F.lane & 31, kh = F.lane >> 5; float acc = 0.f;
            const float* wp = a.w_router + (size_t)(kh * 1024) * NE + e; const LAS float* hp = hs + kh * 1024;
#pragma unroll 16
            for (int k = 0; k < 1024; ++k) acc += hp[k] * wp[(size_t)k * NE];
            acc += __shfl_xor(acc, 32);
            float val = (F.lane < 32) ? acc + a.b_router[e] : -INFINITY;
            float sv[4]; int si[4];
#pragma unroll
            for (int r = 0; r < 4; ++r) { float mv = val; int mi = F.lane;
#pragma unroll
                for (int o = 1; o < 32; o <<= 1) { const float ov = __shfl_xor(mv, o); const int oi = __shfl_xor(mi, o); if (ov > mv || (ov == mv && oi < mi)) { mv = ov; mi = oi; } }
                mv = __shfl(mv, 0); mi = __shfl(mi, 0); sv[r] = mv; si[r] = mi; if (F.lane == mi) val = -INFINITY; }
            const float e1 = __expf(sv[1] - sv[0]), e2 = __expf(sv[2] - sv[0]), e3 = __expf(sv[3] - sv[0]), inv = 1.f / (1.f + e1 + e2 + e3);
            if (F.lane == 0) { *(int4*)(TOPE + (size_t)m * 4) = make_int4(si[0], si[1], si[2], si[3]); *(f32x4*)(TOPW + (size_t)m * 4) = (f32x4){inv, e1 * inv, e2 * inv, e3 * inv};
                atomicAdd((int*)&cnt[si[0]], 1); atomicAdd((int*)&cnt[si[1]], 1); atomicAdd((int*)&cnt[si[2]], 1); atomicAdd((int*)&cnt[si[3]], 1); }
            LDS_WAIT(); asm volatile("" ::: "memory");
        }
        __syncthreads();
        if (F.tid < NE) HIST[vb * NE + F.tid] = cnt[F.tid];
    }
    __syncthreads();
}
struct URow { f32x4 x[8]; v2u g[8]; };
__device__ __forceinline__ void urow_load(URow& r, const float* x, const bf16* mixg, int m, int lane) {
    load_row(x + (size_t)m * D, lane, r.x); const GAS v2u* gp = (const GAS v2u*)(mixg + (size_t)m * D) + lane;
#pragma unroll
    for (int j = 0; j < 8; ++j) r.g[j] = gp[64 * j];
}
__device__ __forceinline__ void lnr_stage_a(const Frame& F, const Args& a, int m, int r, const URow& ur, LAS float* hT, float* X1, bf16* H, const float* ada) {
    GAS unsigned* h8 = (GAS unsigned*)(a.ws + WS_H8 + (size_t)m * D) + F.lane;
    f32x4 v[8];
#pragma unroll
    for (int j = 0; j < 8; ++j) v[j] = ur.x[j] * DN_ALPHA + (f32x4){bflo(ur.g[j].x), bfhi(ur.g[j].x), bflo(ur.g[j].y), bfhi(ur.g[j].y)};
    const int b = m / T; float mean, rstd; row_stats(v, mean, rstd);
    GAS f32x4* xo = (GAS f32x4*)(X1 + (size_t)m * D) + F.lane;
#pragma unroll
    for (int j = 0; j < 8; ++j) { const int c0 = 4 * (F.lane + 64 * j); v[j] = (v[j] - mean) * rstd * *(const f32x4*)(a.ln1_g + c0) + *(const f32x4*)(a.ln1_b + c0);
        if (X1BF) { v2u w; w.x = pk2(v[j].x, v[j].y); w.y = pk2(v[j].z, v[j].w); ((GAS v2u*)((bf16*)X1 + (size_t)m * D) + F.lane)[64 * j] = w; } else xo[64 * j] = v[j]; }
    row_stats(v, mean, rstd);
    const float* sh = ada + b * 6 * D + 3 * D; const float* sc = sh + D;
    GAS v2u* ho = (GAS v2u*)(H + (size_t)m * D) + F.lane;
#pragma unroll
    for (int j = 0; j < 8; ++j) { const int kg = F.lane + 64 * j, c0 = 4 * kg; const f32x4 y = (v[j] - mean) * rstd * (*(const f32x4*)(sc + c0) + 1.f) + *(const f32x4*)(sh + c0);
        if (FP8MOE) h8[64 * j] = pk4_fp8(y.x, y.y, y.z, y.w); else { v2u w; w.x = pk2(y.x, y.y); w.y = pk2(y.z, y.w); ho[64 * j] = w; }
        *(LAS f32x4*)(hT + (kg * 16 + (r ^ (kg & 15))) * 4) = y; }
}
__device__ __forceinline__ void phase_ln_router_mfma(const Frame& F, const Args& a) {
    const float* U = (const float*)(a.ws + WS_U); float* X1 = (float*)(a.ws + WS_X1); bf16* H = (bf16*)(a.ws + WS_H); const float* ada = (const float*)(a.ws + WS_ADA);
    int* TOPE = (int*)(a.ws + WS_TOPE); float* TOPW = (float*)(a.ws + WS_TOPW); int* HIST = (int*)(a.ws + WS_HIST);
    LAS float* hT = (LAS float*)F.lds;
    LAS float* Pp = (LAS float*)(F.lds + 131072);
    LAS int* cnt = (LAS int*)(F.lds + 131072 + 16384);
    const bf16* MIXG = (const bf16*)(a.ws + WS_U);
    URow va, vb2;
    if (F.bid < 256) { urow_load(va, a.x, MIXG, F.bid * 64 + 2 * F.wave, F.lane); urow_load(vb2, a.x, MIXG, F.bid * 64 + 2 * F.wave + 1, F.lane); }
    for (int vb = F.bid; vb < 256; vb += F.G) {
        __syncthreads();
        if (F.tid < NE) cnt[F.tid] = 0;
        for (int bt = 0; bt < 4; ++bt) {
            __syncthreads();
            const int mb = vb * 64 + bt * 16;
            lnr_stage_a(F, a, mb + 2 * F.wave, 2 * F.wave, va, hT, X1, H, ada);
            lnr_stage_a(F, a, mb + 2 * F.wave + 1, 2 * F.wave + 1, vb2, hT, X1, H, ada);
            __syncthreads();
            { const int nmb = (bt < 3) ? mb + 16 : (vb + F.G) * 64;
              if (nmb < M) { urow_load(va, a.x, MIXG, nmb + 2 * F.wave, F.lane); urow_load(vb2, a.x, MIXG, nmb + 2 * F.wave + 1, F.lane); } }
            { const int i = F.lane & 15, kk = F.lane >> 4; f32x4 acc0 = (f32x4){0.f, 0.f, 0.f, 0.f}, acc1 = (f32x4){0.f, 0.f, 0.f, 0.f};
              const float* wp = a.w_router + (size_t)(256 * F.wave + kk) * NE + i;
#pragma unroll 8
              for (int ks = 0; ks < 64; ++ks) { const int kg = 64 * F.wave + ks; const float av = hT[(kg * 16 + (i ^ (kg & 15))) * 4 + kk];
                  const float b0 = wp[(size_t)ks * 4 * NE], b1 = wp[(size_t)ks * 4 * NE + 16];
                  acc0 = __builtin_amdgcn_mfma_f32_16x16x4f32(av, b0, acc0, 0, 0, 0); acc1 = __builtin_amdgcn_mfma_f32_16x16x4f32(av, b1, acc1, 0, 0, 0); }
#pragma unroll
              for (int rg = 0; rg < 4; ++rg) { Pp[(F.wave * 16 + 4 * kk + rg) * 32 + i] = acc0[rg]; Pp[(F.wave * 16 + 4 * kk + rg) * 32 + 16 + i] = acc1[rg]; } }
            __syncthreads();
            for (int rr = 0; rr < 2; ++rr) {
                const int r = 2 * F.wave + rr, m = mb + r; const int e = F.lane & 31;
                float val = a.b_router[e];
#pragma unroll
                for (int w2 = 0; w2 < 8; ++w2) val += Pp[(w2 * 16 + r) * 32 + e];
                if (F.lane >= 32) val = -INFINITY;
                float sv[4]; int si[4];
#pragma unroll
                for (int q = 0; q < 4; ++q) { float mv = val; int mi = F.lane;
#pragma unroll
                    for (int o = 1; o < 32; o <<= 1) { const float ov = __shfl_xor(mv, o); const int oi = __shfl_xor(mi, o); if (ov > mv || (ov == mv && oi < mi)) { mv = ov; mi = oi; } }
                    mv = __shfl(mv, 0); mi = __shfl(mi, 0); sv[q] = mv; si[q] = mi; if (F.lane == mi) val = -INFINITY; }
                const float e1 = __expf(sv[1] - sv[0]), e2 = __expf(sv[2] - sv[0]), e3 = __expf(sv[3] - sv[0]), inv = 1.f / (1.f + e1 + e2 + e3);
                if (F.lane == 0) { *(int4*)(TOPE + (size_t)m * 4) = make_int4(si[0], si[1], si[2], si[3]); *(f32x4*)(TOPW + (size_t)m * 4) = (f32x4){inv, e1 * inv, e2 * inv, e3 * inv};
                    atomicAdd((int*)&cnt[si[0]], 1); atomicAdd((int*)&cnt[si[1]], 1); atomicAdd((int*)&cnt[si[2]], 1); atomicAdd((int*)&cnt[si[3]], 1); }
            }
        }
        __syncthreads();
        if (F.tid < NE) HIST[vb * NE + F.tid] = cnt[F.tid];
    }
    __syncthreads();
}
__device__ __forceinline__ void phase_moe_sort(const Frame& F, const Args& a) {
    const int* TOPE = (const int*)(a.ws + WS_TOPE); const float* TOPW = (const float*)(a.ws + WS_TOPW); const int* HIST = (const int*)(a.ws + WS_HIST);
    int* POS = (int*)(a.ws + WS_POS); float* ROWW = (float*)(a.ws + WS_ROWW); int* ROWTOK = (int*)(a.ws + WS_ROWW + 512 * 1024); const bf16* H = (const bf16*)(a.ws + WS_H); bf16* XS = (bf16*)(a.ws + WS_XS);
    int* PADG = (int*)(a.ws + WS_CTL) + CW_PAD;
    LAS int* tot = (LAS int*)F.lds; LAS int* bef = tot + 32; LAS int* pst = tot + 64; LAS int* ent = tot + 128; LAS int* pos = tot + 384; LAS int* ptot = tot + 640; LAS int* pbef = tot + 1152; LAS int* cntw = tot + 1664;
    for (int vb = F.bid; vb < 256; vb += F.G) {
        __syncthreads();
        { const int e = F.tid & 31, part = F.tid >> 5; int t = 0, bsum = 0;
#pragma unroll
          for (int i = 0; i < 16; ++i) { const int v = part * 16 + i; const int c = HIST[v * NE + e]; t += c; if (v < vb) bsum += c; }
          ptot[part * 32 + e] = t; pbef[part * 32 + e] = bsum; }
        __syncthreads();
        if (F.tid < NE) { int t = 0, bsum = 0;
#pragma unroll
          for (int p = 0; p < 16; ++p) { t += ptot[p * 32 + F.tid]; bsum += pbef[p * 32 + F.tid]; }
          tot[F.tid] = t; bef[F.tid] = bsum; }
        if (F.tid < 256) ent[F.tid] = TOPE[(size_t)vb * 256 + F.tid];
        __syncthreads();
        if (F.tid == 0) { int run = 0; for (int e = 0; e < NE; ++e) { pst[e] = run; run += ((tot[e] + 255) / 256) * 256; } pst[NE] = run; }
        __syncthreads();
        if (vb == 0 && F.tid <= NE) PADG[F.tid] = pst[F.tid];
        int myrank = 0; const int mye = (F.tid < 256) ? ent[F.tid] : -1;
        if (F.tid < 256) {
#pragma unroll 8
            for (int e = 0; e < NE; ++e) { const unsigned long long mk = __ballot(mye == e); if (mye == e) myrank = __popcll(mk & ((1ull << F.lane) - 1ull)); if (F.lane == 0) cntw[F.wave * NE + e] = __popcll(mk); }
        }
        __syncthreads();
        if (F.tid < 256) { int base = pst[mye] + bef[mye]; for (int w2 = 0; w2 < F.wave; ++w2) base += cntw[w2 * NE + mye]; pos[F.tid] = base + myrank; }
        __syncthreads();
        if (F.tid < 256) { const int p = pos[F.tid]; POS[(size_t)vb * 256 + F.tid] = p; ROWW[p] = TOPW[(size_t)vb * 256 + F.tid]; ROWTOK[p] = vb * 64 + (F.tid >> 2); }
        if (vb == 0 && F.tid < NE) { for (int p = pst[F.tid] + tot[F.tid]; p < pst[F.tid + 1]; ++p) { ROWTOK[p] = 0; ROWW[p] = 0.f; } }
#if !(FAST & 512)
        for (int i = F.wave; i < 256; i += 8) { const int p = pos[i], tok = vb * 64 + (i >> 2);
            const GAS v4u* src = (const GAS v4u*)(H + (size_t)tok * D) + F.lane; GAS v4u* dst = (GAS v4u*)(XS + (size_t)p * D) + F.lane;
#pragma unroll
            for (int q = 0; q < 4; ++q) dst[64 * q] = src[64 * q]; }
#endif
    }
    __syncthreads();
}
struct EpiSwiglu { const float* bgu; bf16* act;
    __device__ __forceinline__ void operator()(const STile& t, int row, int col, float g, float u) const {
        const float* be = bgu + (size_t)t.aux * 2 * FF; g += be[2 * col]; u += be[2 * col + 1];
        g = fminf(g, 7.f); u = fminf(fmaxf(u, -7.f), 7.f);
        act[(size_t)row * FF + col] = (bf16)f2bf((u + 1.f) * g * sigmoidf_(1.702f * g)); } };
struct EpiDown { const float* bd; const float* roww; bf16* ys;
    __device__ __forceinline__ void operator()(const STile& t, int row, int col, float v, float) const { ys[(size_t)row * D + col] = (bf16)f2bf((v + bd[(size_t)t.aux * D + col]) * roww[row]); } };
__device__ __forceinline__ void phase_combine(const Frame& F, const Args& a) {
    const float* X1 = (const float*)(a.ws + WS_X1); const bf16* YS = (const bf16*)(a.ws + WS_YS); const int* POS = (const int*)(a.ws + WS_POS); const float* ada = (const float*)(a.ws + WS_ADA);
    const int gw = F.bid * 8 + F.wave, NGW = F.G * 8;
    for (int m = gw; m < M; m += NGW) {
        const int b = m / T; const int4 ps = *(const int4*)(POS + (size_t)m * 4);
        f32x4 v[8];
        if (X1BF) { const GAS v2u* xp = (const GAS v2u*)((const bf16*)X1 + (size_t)m * D) + F.lane;
#pragma unroll
            for (int j = 0; j < 8; ++j) { const v2u r = xp[64 * j]; v[j] = (f32x4){bflo(r.x), bfhi(r.x), bflo(r.y), bfhi(r.y)}; } }
        else load_row(X1 + (size_t)m * D, F.lane, v);
        const GAS v2u* y0 = (const GAS v2u*)(YS + (size_t)ps.x * D) + F.lane; const GAS v2u* y1 = (const GAS v2u*)(YS + (size_t)ps.y * D) + F.lane;
        const GAS v2u* y2 = (const GAS v2u*)(YS + (size_t)ps.z * D) + F.lane; const GAS v2u* y3 = (const GAS v2u*)(YS + (size_t)ps.w * D) + F.lane;
        const float* gt = ada + b * 6 * D + 5 * D;
#pragma unroll
        for (int j = 0; j < 8; ++j) { const int c0 = 4 * (F.lane + 64 * j);
#if YS8
            const unsigned q0 = ((const GAS unsigned*)((const unsigned char*)YS + (size_t)ps.x * D) + F.lane)[64 * j], q1 = ((const GAS unsigned*)((const unsigned char*)YS + (size_t)ps.y * D) + F.lane)[64 * j];
            const unsigned q2 = ((const GAS unsigned*)((const unsigned char*)YS + (size_t)ps.z * D) + F.lane)[64 * j], q3 = ((const GAS unsigned*)((const unsigned char*)YS + (size_t)ps.w * D) + F.lane)[64 * j];
            typedef float v2f_t __attribute__((__vector_size__(8)));
            v2f_t lo = __builtin_amdgcn_cvt_pk_f32_fp8((int)q0, false), hi = __builtin_amdgcn_cvt_pk_f32_fp8((int)q0, true);
            lo += __builtin_amdgcn_cvt_pk_f32_fp8((int)q1, false); hi += __builtin_amdgcn_cvt_pk_f32_fp8((int)q1, true);
            lo += __builtin_amdgcn_cvt_pk_f32_fp8((int)q2, false); hi += __builtin_amdgcn_cvt_pk_f32_fp8((int)q2, true);
            lo += __builtin_amdgcn_cvt_pk_f32_fp8((int)q3, false); hi += __builtin_amdgcn_cvt_pk_f32_fp8((int)q3, true);
            const f32x4 f = (f32x4){lo[0], lo[1], hi[0], hi[1]} * 0.0625f;
#else
            const v2u r0 = y0[64 * j], r1 = y1[64 * j], r2 = y2[64 * j], r3 = y3[64 * j];
            f32x4 f = (f32x4){bflo(r0.x), bfhi(r0.x), bflo(r0.y), bfhi(r0.y)}; f += (f32x4){bflo(r1.x), bfhi(r1.x), bflo(r1.y), bfhi(r1.y)};
            f += (f32x4){bflo(r2.x), bfhi(r2.x), bflo(r2.y), bfhi(r2.y)}; f += (f32x4){bflo(r3.x), bfhi(r3.x), bflo(r3.y), bfhi(r3.y)};
#endif
            v[j] = v[j] * DN_ALPHA + *(const f32x4*)(gt + c0) * f; }
        float mean, rstd; row_stats(v, mean, rstd);
        GAS f32x4* o = (GAS f32x4*)(a.out + (size_t)m * D) + F.lane;
#pragma unroll
        for (int j = 0; j < 8; ++j) { const int c0 = 4 * (F.lane + 64 * j); o[64 * j] = (v[j] - mean) * rstd * *(const f32x4*)(a.ln2_g + c0) + *(const f32x4*)(a.ln2_b + c0); }
    }
}

constexpr int N_PHASES = 13;
__global__ void __launch_bounds__(512, 2) fwd(Args args) {
    extern __shared__ __attribute__((aligned(16))) unsigned char lds_raw[];
    Frame F; F.lds = (LAS unsigned char*)lds_raw; F.tid = threadIdx.x; F.lane = F.tid & 63; F.wave = __builtin_amdgcn_readfirstlane(F.tid >> 6); F.G = gridDim.x; F.bid = blockIdx.x;
    volatile LAS unsigned* MISC = (volatile LAS unsigned*)(F.lds + MISC_OFF);
    if (F.tid < 32) MISC[F.tid] = 0u;
    __syncthreads();
    unsigned* ctl = (unsigned*)(args.ws + WS_CTL);
    XcdBarrier bar; bar.bar = ctl + CW_BAR; bar.x = 0; bar.st = nullptr;
    if (MK_ONE_LAUNCH) bar = xcd_barrier_post(ctl + CW_BAR, MISC + 8);
    const int lo = args.ph_lo, hi = args.ph_hi;
    unsigned char* ws = args.ws;
#ifndef PH_MASK
#define PH_MASK 0x1fff
#endif
#define IN(k) (((PH_MASK >> (k)) & 1) && lo <= (k) && (k) < hi)
#define SEAM(k) do { if (IN(k) && IN((k) + 1)) xcd_barrier(bar); } while (0)
    if (IN(0)) { REPN(0) phase_prologue(F, args); } SEAM(0);
    if (IN(1)) { REPN(1) phase_lnmod1(F, args); } SEAM(1);
    if (IN(2)) {
#if FAST & 1
        const int ng = (NCONV > 0 && F.G > NCONV && (F.G % 8) == 0) ? F.G - NCONV : F.G;
        if (F.bid < ng) {
            constexpr int NBF = NPAD;
            pg8::Gemm g{(const bf16*)(ws + WS_H), (const bf16*)(ws + WS_WINT), M, NBF, D}; pg8::SkipOrder S; S.init(M, (T8LO + 1) * 256, ng, F.bid); S.t8 = T8LO; pg8::EpiProjF E{(bf16*)(ws + WS_PROJ), (float*)(ws + WS_ALR), (bf16*)(ws + WS_QAF), (bf16*)(ws + WS_KAF), (bf16*)(ws + WS_VAF), (bf16*)(ws + WS_VGT)};
#if ALR8
            static_assert(!ALR8 || C8_LO == 0, "ALR8 needs the whole in-projection in the fp8 call");
            { (void)g; (void)S; pg8::Gemm g8{(const bf16*)(ws + WS_H8A), (const bf16*)(ws + WS_WG8), M, N8 + 256, D, 0x7f7f7f7fu, 0x79797979u}; pg8::GateOrder8 S8; S8.init(M, N8 + 256, ng, F.bid); S8.t8 = 0;
              pg8::gemm_phase<pg8::EpiProjF, pg8::GateOrder8, true, true, false, 1>(F.lds, g8, S8, E); }
#elif FP8GATE
            REPN(2) pg8::gemm_phase<pg8::EpiProjF, pg8::SkipOrder, true, true>(F.lds, g, S, E);
            { pg8::Gemm g8{(const bf16*)(ws + WS_H8A), (const bf16*)(ws + WS_WG8), M, N8, D, 0x7f7f7f7fu, 0x79797979u}; pg8::GateOrder8 S8; S8.init(M, N8, ng, ng - 8 - (F.bid & ~7) + (F.bid & 7)); S8.t8 = T8LO;
              pg8::gemm_phase<pg8::EpiProjF, pg8::GateOrder8, true, true, false, 1>(F.lds, g8, S8, E); }
#endif
            if (ng == F.G) phase_convert_moe(F, args, F.bid, F.G);
        } else {
#if FP8MOE && CONV_DMA
            phase_convert_moe_dma(F, args, F.bid - ng, F.G - ng);
#else
            phase_convert_moe(F, args, F.bid - ng, F.G - ng);
#endif
        }
#else
        DenseTiles TL{(const bf16*)(ws + WS_H), (const bf16*)(ws + WS_WINT), M, NPAD, D}; EpiProj E{(bf16*)(ws + WS_PROJ), (float*)(ws + WS_ALR), (bf16*)(ws + WS_VAT), (bf16*)(ws + WS_VGT), (bf16*)(ws + WS_QAF), (bf16*)(ws + WS_KAF), (bf16*)(ws + WS_VAF)}; sgemm_phase<false>(F, D, TL, E);
        phase_convert_moe(F, args, F.bid, F.G);
#endif
    } SEAM(2);
    if (IN(3)) {
#ifndef NO3A
#if FAST & 64
        REPN(3) phase_attn_mfma(F, args);
#else
        REPN(3) phase_attn_simple(F, args);
#endif
#endif
#ifndef NO3B
#if FAST & 128
        REPN(14) phase_gla_prep_mfma(F, args);
#else
        REPN(14) phase_gla_prep_simple(F, args);
#endif
#endif
    } SEAM(3);
    if (IN(4)) {
#if FAST & 128
        REPN(4) phase_gla_scan_mfma(F, args);
#else
        REPN(4) phase_gla_scan_simple(F, args);
#endif
#if FAST & 2
#if FP8PA
        pg8::Gemm g{(const bf16*)(ws + WS_YATT), (const bf16*)(ws + WS_PA8), M, D, 1024, 0x7b7b7b7bu, 0x79797979u}; pg8::StaticOrder S; S.init(M, D, F.G, F.bid); pg8::EpiT1F E{(const bf16*)(ws + WS_PROJ), (bf16*)(ws + WS_T1)};
        pg8::gemm_phase<pg8::EpiT1F, pg8::StaticOrder, true, true, false, 1>(F.lds, g, S, E);
#else
        pg8::Gemm g{(const bf16*)(ws + WS_YATT), (const bf16*)(ws + WS_PAT), M, D, 1024}; pg8::StaticOrder S; S.init(M, D, F.G, F.bid); pg8::EpiT1F E{(const bf16*)(ws + WS_PROJ), (bf16*)(ws + WS_T1)};
        pg8::gemm_phase<pg8::EpiT1F, pg8::StaticOrder, true, true>(F.lds, g, S, E);
#endif
#else
        DenseTiles TL{(const bf16*)(ws + WS_YATT), (const bf16*)(ws + WS_PAT), M, D, 1024}; EpiT1 E{(const bf16*)(ws + WS_PROJ), (bf16*)(ws + WS_T1)}; sgemm_phase<false>(F, 1024, TL, E);
#endif
    } SEAM(4);
    if (IN(5)) { REPN(5) phase_gla_finish(F, args); } SEAM(5);
    if (IN(6)) {
#if FAST & 4
#if FP8PG
        pg8::Gemm g{(const bf16*)(ws + WS_YGLA), (const bf16*)(ws + WS_PG8), M, D, D, 0x7c7c7c7cu, 0x79797979u}; pg8::StaticOrder S; S.init(M, D, F.G, F.bid); pg8::EpiMergedF E{(const bf16*)(ws + WS_PROJ), (const bf16*)(ws + WS_T1), (bf16*)(ws + WS_MERGED)};
        REPN(6) pg8::gemm_phase<pg8::EpiMergedF, pg8::StaticOrder, true, true, false, 1>(F.lds, g, S, E);
#else
        pg8::Gemm g{(const bf16*)(ws + WS_YGLA), (const bf16*)(ws + WS_PGT), M, D, D}; pg8::StaticOrder S; S.init(M, D, F.G, F.bid); pg8::EpiMergedF E{(const bf16*)(ws + WS_PROJ), (const bf16*)(ws + WS_T1), (bf16*)(ws + WS_MERGED)};
        REPN(6) pg8::gemm_phase<pg8::EpiMergedF, pg8::StaticOrder, true, true>(F.lds, g, S, E);
#endif
#else
        DenseTiles TL{(const bf16*)(ws + WS_YGLA), (const bf16*)(ws + WS_PGT), M, D, D}; EpiMerged E{(const bf16*)(ws + WS_PROJ), (const bf16*)(ws + WS_T1), (bf16*)(ws + WS_MERGED)}; sgemm_phase<false>(F, D, TL, E);
#endif
    } SEAM(6);
    if (IN(7)) {
#if FAST & 8
#if FP8WO
        pg8::Gemm g{(const bf16*)(ws + WS_MERGED), (const bf16*)(ws + WS_WO8), M, D, D, 0x7b7b7b7bu, 0x79797979u}; pg8::StaticOrder S; S.init(M, D, F.G, F.bid); pg8::EpiUF E{(const float*)(ws + WS_ADA), (bf16*)(ws + WS_U)};
        REPN(7) pg8::gemm_phase<pg8::EpiUF, pg8::StaticOrder, true, true, false, 1>(F.lds, g, S, E);
#else
        pg8::Gemm g{(const bf16*)(ws + WS_MERGED), (const bf16*)(ws + WS_WOT), M, D, D}; pg8::StaticOrder S; S.init(M, D, F.G, F.bid); pg8::EpiUF E{(const float*)(ws + WS_ADA), (bf16*)(ws + WS_U)};
        REPN(7) pg8::gemm_phase<pg8::EpiUF, pg8::StaticOrder, true, true>(F.lds, g, S, E);
#endif
#else
        DenseTiles TL{(const bf16*)(ws + WS_MERGED), (const bf16*)(ws + WS_WOT), M, D, D}; EpiU E{args.x, (const float*)(ws + WS_ADA), (bf16*)(ws + WS_U)}; sgemm_phase<false>(F, D, TL, E);
#endif
    } SEAM(7);
    if (IN(8)) {
#if FAST & 256
        REPN(8) phase_ln_router_mfma(F, args);
#else
        REPN(8) phase_ln_router(F, args);
#endif
    } SEAM(8);
    if (IN(9)) { REPN(9) phase_moe_sort(F, args); } SEAM(9);
    if (IN(10)) {
#if FAST & 16
        const int* padg = (const int*)(ws + WS_CTL) + CW_PAD; LAS unsigned char* t2e = F.lds + 131072;
        const int nMt = __builtin_amdgcn_readfirstlane(padg[NE]) / 256;
        __syncthreads();
        for (int p = F.tid; p < nMt; p += 512) { int e = 0; for (int q = 1; q < NE; ++q) if (p * 256 >= padg[q]) e = q; t2e[p] = (unsigned char)e; }
        __syncthreads();
#if FP8MOE
        pg8::Gemm g{(const bf16*)(ws + WS_H8), (const bf16*)(ws + WS_WGU8), nMt * 256, 2 * FF, D, 0x7f7f7f7fu, 0x79797979u}; pg8::MoeOrder S; S.init(nMt * 256, 2 * FF, F.G, F.bid); S.NT = 2 * FF / 256; S.t2e = t2e;
        { LAS unsigned* gtab = (LAS unsigned*)(F.lds + 131072 + 1024); const int* rowtok = (const int*)(ws + WS_ROWW + 512 * 1024); S.gtab = gtab;
#pragma unroll
          for (int ps = 0; ps < 15; ++ps) { const int i = 2 * ps + (F.tid >> 8); pg8::Unit uu; if (S.next(i, uu)) gtab[i * 256 + (F.tid & 255)] = (unsigned)rowtok[uu.pm * 256 + (F.tid & 255)] * (unsigned)D; }
          __syncthreads(); }
        pg8::EpiSwiglu8 E{args.b_gate_up, ws + WS_ACT8};
        REPN(10) pg8::gemm_phase<pg8::EpiSwiglu8, pg8::MoeOrder, true, true, true, 1>(F.lds, g, S, E);
#elif FAST & 512
        pg8::Gemm g{(const bf16*)(ws + WS_H), (const bf16*)(ws + WS_WGUT), nMt * 256, 2 * FF, D}; pg8::MoeOrder S; S.init(nMt * 256, 2 * FF, F.G, F.bid); S.NT = 2 * FF / 256; S.t2e = t2e;
        { LAS unsigned* gtab = (LAS unsigned*)(F.lds + 131072 + 1024); const int* rowtok = (const int*)(ws + WS_ROWW + 512 * 1024); S.gtab = gtab;
#pragma unroll
          for (int ps = 0; ps < 15; ++ps) { const int i = 2 * ps + (F.tid >> 8); pg8::Unit uu; if (S.next(i, uu)) gtab[i * 256 + (F.tid & 255)] = (unsigned)rowtok[uu.pm * 256 + (F.tid & 255)] * (unsigned)(D * 2); }
          __syncthreads(); }
        pg8::EpiSwigluF E{args.b_gate_up, (bf16*)(ws + WS_ACT)};
        REPN(10) pg8::gemm_phase<pg8::EpiSwigluF, pg8::MoeOrder, true, true, true>(F.lds, g, S, E);
#else
        pg8::Gemm g{(const bf16*)(ws + WS_XS), (const bf16*)(ws + WS_WGUT), nMt * 256, 2 * FF, D}; pg8::MoeOrder S; S.init(nMt * 256, 2 * FF, F.G, F.bid); S.NT = 2 * FF / 256; S.t2e = t2e; S.gtab = nullptr;
        pg8::EpiSwigluF E{args.b_gate_up, (bf16*)(ws + WS_ACT)};
        REPN(10) pg8::gemm_phase<pg8::EpiSwigluF, pg8::MoeOrder, true, true>(F.lds, g, S, E);
#endif
#else
        MoeTiles TL{(const bf16*)(ws + WS_XS), (const bf16*)(ws + WS_WGUT), (const int*)(ws + WS_CTL) + CW_PAD, FF / 128, D, 2 * FF, true}; EpiSwiglu E{args.b_gate_up, (bf16*)(ws + WS_ACT)}; sgemm_phase<true>(F, D, TL, E);
#endif
    } SEAM(10);
    if (IN(11)) {
#if FAST & 32
        const int* padg = (const int*)(ws + WS_CTL) + CW_PAD; LAS unsigned char* t2e = F.lds + 131072;
        const int nMt = __builtin_amdgcn_readfirstlane(padg[NE]) / 256;
        __syncthreads();
        for (int p = F.tid; p < nMt; p += 512) { int e = 0; for (int q = 1; q < NE; ++q) if (p * 256 >= padg[q]) e = q; t2e[p] = (unsigned char)e; }
        __syncthreads();
#if FP8MOE
        pg8::Gemm g{(const bf16*)(ws + WS_ACT8), (const bf16*)(ws + WS_WDN8), nMt * 256, D, FF, 0x7d7d7d7du, 0x79797979u}; pg8::MoeOrder S; S.init(nMt * 256, D, F.G, F.bid); S.NT = D / 256; S.t2e = t2e; S.gtab = nullptr;
        pg8::EpiDownF E{args.b_down, (const float*)(ws + WS_ROWW), (bf16*)(ws + WS_YS)};
        REPN(11) pg8::gemm_phase<pg8::EpiDownF, pg8::MoeOrder, true, true, false, 1>(F.lds, g, S, E);
#else
        pg8::Gemm g{(const bf16*)(ws + WS_ACT), (const bf16*)(ws + WS_WDNT), nMt * 256, D, FF}; pg8::MoeOrder S; S.init(nMt * 256, D, F.G, F.bid); S.NT = D / 256; S.t2e = t2e; S.gtab = nullptr;
        pg8::EpiDownF E{args.b_down, (const float*)(ws + WS_ROWW), (bf16*)(ws + WS_YS)};
        REPN(11) pg8::gemm_phase<pg8::EpiDownF, pg8::MoeOrder, true, true>(F.lds, g, S, E);
#endif
#else
        MoeTiles TL{(const bf16*)(ws + WS_ACT), (const bf16*)(ws + WS_WDNT), (const int*)(ws + WS_CTL) + CW_PAD, D / 128, FF, D, false}; EpiDown E{args.b_down, (const float*)(ws + WS_ROWW), (bf16*)(ws + WS_YS)}; sgemm_phase<false>(F, FF, TL, E);
#endif
    } SEAM(11);
    if (IN(12)) { REPN(12) phase_combine(F, args); }
#undef IN
#undef SEAM
}

extern "C" void kernel_launch(void* const* d_in, const int* in_sizes, int n_in, void* d_out, int out_size, void* d_ws, size_t ws_size, hipStream_t stream) {
    static int grid = 0;
    if (grid == 0) {
        if (n_in != 22 || in_sizes[0] != M * D || out_size != M * D || ws_size < WS_END) { fprintf(stderr, "kernel_launch: unexpected shapes (n_in %d, in0 %d, out %d, ws %zu)\n", n_in, n_in > 0 ? in_sizes[0] : -1, out_size, ws_size); grid = -1; return; }
        int dev = 0, cus = 0, per_cu = 0;
        if (hipGetDevice(&dev) != hipSuccess || hipDeviceGetAttribute(&cus, hipDeviceAttributeMultiprocessorCount, dev) != hipSuccess) { grid = -1; return; }
        if (hipFuncSetAttribute((const void*)fwd, hipFuncAttributeMaxDynamicSharedMemorySize, LDS_BYTES) != hipSuccess) { fprintf(stderr, "kernel_launch: hipFuncSetAttribute failed\n"); grid = -1; return; }
        if (hipOccupancyMaxActiveBlocksPerMultiprocessor(&per_cu, (const void*)fwd, 512, LDS_BYTES) != hipSuccess || per_cu < 1) fprintf(stderr, "kernel_launch: occupancy query reports %d\n", per_cu);
        (void)hipGetLastError();
        grid = cus;
    }
    if (grid < 0) return;
    (void)hipMemsetAsync((char*)d_ws + WS_CTL, 0, CTL_ZERO_BYTES, stream);
    Args a{};
    const float** ap = (const float**)&a;
    for (int i = 0; i < 22; ++i) ap[i] = (const float*)d_in[i];
    a.out = (float*)d_out; a.ws = (unsigned char*)d_ws;
    if (MK_ONE_LAUNCH) { a.ph_lo = 0; a.ph_hi = N_PHASES; hipLaunchKernelGGL(fwd, dim3(grid), dim3(512), LDS_BYTES, stream, a); }
    else for (int p = 0; p < N_PHASES; ++p) { a.ph_lo = p; a.ph_hi = p + 1; hipLaunchKernelGGL(fwd, dim3(grid), dim3(512), LDS_BYTES, stream, a); }
}
```

```cpp
#include <hip/hip_runtime.h>
#include <cstdio>
#include <cstdint>

#define LAS __attribute__((address_space(3)))
#define GAS __attribute__((address_space(1)))
typedef unsigned short bf16;
typedef short bf16x8 __attribute__((ext_vector_type(8)));
typedef float f32x4 __attribute__((ext_vector_type(4)));
typedef unsigned v4u __attribute__((ext_vector_type(4)));
typedef unsigned v2u __attribute__((ext_vector_type(2)));
typedef GAS unsigned gu32;

#ifndef REP_MASK
#define REP_MASK 0
#endif
#define REPN(bit) for (int rep_ = 0; rep_ < 1 + ((REP_MASK >> (bit)) & 1); ++rep_)
#ifndef FAST
#define FAST 1023
#endif
#ifndef FP8GATE
#define FP8GATE 1
#endif
#ifndef CONV_DMA
#define CONV_DMA 1
#endif
#ifndef FP8MOE
#define FP8MOE 1
#endif
#ifndef NCONV
#define NCONV 80
#endif
#ifndef MK_ONE_LAUNCH
#define MK_ONE_LAUNCH 1
#endif

constexpr int D = 2048, NB = 4, T = 4096, M = NB * T;
constexpr int AH = 16, AKV = 2, AD = 64, WIN = 128;
constexpr int GH = 4, GDK = 1024, GDV = 2048, GHK = 256, GHV = 512, GR = 16, GC = 64, GNC = T / GC;
constexpr int NE = 32, TOPK = 4, FF = 2048;
constexpr int IN_COLS = 11536;
constexpr int PJ = 11520;
constexpr int NPAD = 11776;
constexpr int C_QA = 0, C_KA = 1024, C_VA = 1152, C_QG = 1280, C_KG = 2304, C_VG = 3328, C_RG = 5376, C_GA = 7424, C_GG = 9472;
constexpr int SRC_ALR = 7424;
#ifndef FP8WO
#define FP8WO 1
#endif
#ifndef FP8PG
#define FP8PG 1
#endif
#ifndef X1BF
#define X1BF 1
#endif
#ifndef YS8
#define YS8 1
#endif
#ifndef FP8PA
#define FP8PA 1
#endif
#ifndef ALR8
#define ALR8 1
#endif
#ifndef ITEM_NBFAST
#define ITEM_NBFAST 1
#endif
constexpr int CONV_PAIRS = 32 * (32 * 64 + 32 * 32) / 2;
constexpr int HELP_LO = (64 * 46) % (256 - NCONV);
constexpr int HELP_B = HELP_LO > 0 ? 10 * 4 * (256 - NCONV - HELP_LO) : 0;
constexpr int HELP_A = HELP_LO > 0 ? 1 * 4 * HELP_LO : 0;
constexpr int HELP_PAIRS = HELP_A + HELP_B;
#ifndef C8_LO
#define C8_LO 0
#endif
constexpr int N8 = 11520 - C8_LO, T8LO = C8_LO / 256;
constexpr float LN_EPS = 1e-5f;
constexpr float DN_ALPHA = 1.189207115002721f;
constexpr int CAP = M * TOPK + NE * 256;

constexpr size_t MiB = 1u << 20;
constexpr size_t WS_CTL = 0, CTL_ZERO_BYTES = 128 * 1024;
constexpr size_t WS_ADA = 1 * MiB, WS_HIST = 2 * MiB, WS_TOPE = 3 * MiB, WS_TOPW = 4 * MiB, WS_POS = 5 * MiB, WS_ROWW = 6 * MiB, WS_ALR = 7 * MiB, WS_DLAST = 8 * MiB;
constexpr size_t WS_AMAT = 9 * MiB, WS_PAT = 17 * MiB, WS_PGT = 21 * MiB, WS_WOT = 29 * MiB, WS_WINT = 37 * MiB, WS_H = 84 * MiB, WS_PROJ = 148 * MiB;
constexpr size_t WS_YATT = 508 * MiB, WS_QE = 540 * MiB, WS_KEND = 572 * MiB, WS_OG = 604 * MiB, WS_YGLA = 732 * MiB, WS_T1 = 796 * MiB, WS_MERGED = 924 * MiB;
constexpr size_t WS_U = 988 * MiB, WS_X1 = 1116 * MiB, WS_XS = 1244 * MiB, WS_ACT = 1532 * MiB, WS_YS = 1820 * MiB, WS_WGUT = 2108 * MiB, WS_WDNT = 2620 * MiB, WS_VAT = 2876 * MiB, WS_VGT = 2880 * MiB, WS_QEF = 2944 * MiB, WS_KEF = 2976 * MiB, WS_AMF = 3008 * MiB, WS_END = 3016 * MiB;
constexpr size_t WS_WG8 = WS_XS + 144 * MiB, WS_H8A = WS_XS + 112 * MiB;
constexpr size_t WS_PG8 = WS_XS + 184 * MiB;
constexpr size_t WS_PA8 = WS_XS + 192 * MiB;
constexpr size_t WS_WO8 = WS_XS + 176 * MiB;
constexpr size_t WS_H8 = WS_XS + 64 * MiB, WS_WGU8 = WS_WGUT, WS_WDN8 = WS_WDNT, WS_ACT8 = WS_ACT;
constexpr size_t WS_QAF = WS_XS, WS_KAF = WS_XS + 32 * MiB, WS_VAF = WS_XS + 36 * MiB;
static_assert(WS_WINT + (size_t)NPAD * D * 2 <= WS_H && WS_PROJ + (size_t)M * PJ * 2 <= WS_YATT && WS_XS + (size_t)CAP * D * 2 <= WS_ACT, "ws map");
constexpr int CW_TMO = 0, CW_BAR = 4096, CW_PAD = 16384;

constexpr int LDS_BYTES = 163840;
constexpr int MISC_OFF = 163584;

#define RLX_AGENT __ATOMIC_RELAXED, __HIP_MEMORY_SCOPE_AGENT
#define LDS_WAIT() asm volatile("s_waitcnt lgkmcnt(0)" ::: "memory")
#define VM_WAIT() asm volatile("s_waitcnt vmcnt(0)" ::: "memory")

__device__ __forceinline__ unsigned pk2(float lo, float hi) { unsigned r; asm("v_cvt_pk_bf16_f32 %0, %1, %2" : "=v"(r) : "v"(lo), "v"(hi)); return r; }
__device__ __forceinline__ unsigned f2bf(float f) { return pk2(f, 0.f) & 0xffffu; }
__device__ __forceinline__ unsigned pk4_fp8(float a, float b, float c, float d) { int p = 0; p = __builtin_amdgcn_cvt_pk_fp8_f32(a, b, p, false); p = __builtin_amdgcn_cvt_pk_fp8_f32(c, d, p, true); return (unsigned)p; }
__device__ __forceinline__ float bf2f(unsigned short b) { return __builtin_bit_cast(float, (unsigned)b << 16); }
__device__ __forceinline__ float bflo(unsigned w) { return __builtin_bit_cast(float, w << 16); }
__device__ __forceinline__ float bfhi(unsigned w) { return __builtin_bit_cast(float, w & 0xffff0000u); }
__device__ __forceinline__ float wave_sum(float v) {
#pragma unroll
    for (int o = 1; o < 64; o <<= 1) v += __shfl_xor(v, o);
    return v;
}
__device__ __forceinline__ float sigmoidf_(float x) { return __builtin_amdgcn_rcpf(1.f + __builtin_amdgcn_exp2f(-1.4426950408889634f * x)); }
__device__ __forceinline__ float siluf_(float x) { return x * sigmoidf_(x); }

#define XB_TMO      128
#define XB_XCNT(j)  (256  + 64 * (j))
#define XB_XSUB(j)  (1280 + 64 * (j))
#define XB_XGEN(j)  (2304 + 64 * (j))
#define XB_TOP      3328
#define XB_TOPGEN   3392
#define XCD_BAR_WORDS 3456
#define XB_SPIN_CAP (1u << 22)
__device__ __forceinline__ unsigned xb_ld(unsigned* p)              { return __hip_atomic_load(p, __ATOMIC_RELAXED, __HIP_MEMORY_SCOPE_AGENT); }
__device__ __forceinline__ unsigned xb_add(unsigned* p, unsigned v) { return __hip_atomic_fetch_add(p, v, __ATOMIC_RELAXED, __HIP_MEMORY_SCOPE_AGENT); }
__device__ __forceinline__ unsigned xb_xcc_id() { return (unsigned)__builtin_amdgcn_s_getreg((3 << 11) | 20) & 0xFu; }
#define XB_SPIN(cond, bar) do { unsigned _sp = 0; while (cond) { __builtin_amdgcn_s_sleep(1); \
    if ((++_sp & 255u) == 0u) { if (xb_ld(&(bar)[XB_TMO])) break; if (_sp > XB_SPIN_CAP) { atomicAdd(&(bar)[XB_TMO], 1u); break; } } } } while (0)
struct XcdBarrier { unsigned* bar; unsigned x; volatile LAS unsigned* st; };
__device__ __forceinline__ XcdBarrier xcd_barrier_post(unsigned* bar, volatile LAS unsigned* st) {
    XcdBarrier b; b.bar = bar; b.x = xb_xcc_id(); b.st = st;
    if (threadIdx.x == 0) (void)xb_add(&bar[XB_XCNT(b.x)], 1u);
    return b;
}
__device__ __forceinline__ void xcd_barrier_complete(unsigned* bar, unsigned x, unsigned& nloc, unsigned& nx) {
    const unsigned G = gridDim.x * gridDim.y * gridDim.z;
    unsigned sum, cnt, mine, sp = 0u;
    for (;;) {
        sum = 0u; cnt = 0u; mine = 0u;
#pragma unroll
        for (unsigned j = 0; j < 16; ++j) { const unsigned c = xb_ld(&bar[XB_XCNT(j)]); sum += c; cnt += (c > 0u) ? 1u : 0u; mine = (j == x) ? c : mine; }
        if (sum == G) break;
        __builtin_amdgcn_s_sleep(1);
        if ((++sp & 255u) == 0u) { if (xb_ld(&bar[XB_TMO])) break; if (sp > XB_SPIN_CAP) { atomicAdd(&bar[XB_TMO], 1u); break; } }
    }
    nloc = mine > 0u ? mine : 1u; nx = cnt > 0u ? cnt : 1u;
}
__device__ __forceinline__ void xcd_barrier(const XcdBarrier& b) {
    asm volatile("s_waitcnt vmcnt(0)" ::: "memory");
    __syncthreads();
    if (threadIdx.x == 0) {
        unsigned* bar = b.bar;
        __builtin_amdgcn_s_waitcnt(0);
        unsigned nloc = b.st[0], nx = b.st[1];
        if (nloc == 0u) { xcd_barrier_complete(bar, b.x, nloc, nx); b.st[0] = nloc; b.st[1] = nx; }
        const unsigned old = xb_add(&bar[XB_XSUB(b.x)], 1u);
        const unsigned gen = old / nloc;
        if (old + 1u == (gen + 1u) * nloc) {
            __builtin_amdgcn_fence(__ATOMIC_RELEASE, "agent");
            asm volatile("s_waitcnt vmcnt(0)" ::: "memory");
            const unsigned og = xb_add(&bar[XB_TOP], 1u);
            const unsigned tg = og / nx;
            if (og + 1u == (tg + 1u) * nx) xb_add(&bar[XB_TOPGEN], 1u);
            else XB_SPIN(xb_ld(&bar[XB_TOPGEN]) == tg, bar);
            __builtin_amdgcn_fence(__ATOMIC_ACQUIRE, "agent");
            xb_add(&bar[XB_XGEN(b.x)], 1u);
            asm volatile("s_waitcnt vmcnt(0)" ::: "memory");
        } else {
            XB_SPIN(xb_ld(&bar[XB_XGEN(b.x)]) == gen, bar);
            __builtin_amdgcn_fence(__ATOMIC_ACQUIRE, "agent");
            asm volatile("s_waitcnt vmcnt(0)" ::: "memory");
        }
    }
    __syncthreads();
}

struct Args {
    const float *x, *c, *w_ada, *b_ada, *w_in, *w_gla_up, *b_gla_gate, *sinks, *gla_gain, *w_br_att, *w_br_gla, *w_out, *ln1_g, *ln1_b,
                *w_router, *b_router, *w_gate_up, *b_gate_up, *w_down, *b_down, *ln2_g, *ln2_b;
    float* out; unsigned char* ws; int ph_lo, ph_hi;
};
struct Frame {
    LAS unsigned char* lds; int tid, lane, wave, G, bid;
};

struct STile { const bf16* A; const bf16* B0; const bf16* B1; int row0, col0, aux; };
template <bool DUAL, class Tiles, class Epi>
__device__ __forceinline__ void sgemm_phase(const Frame& F, int K, const Tiles& TL, const Epi& E) {
    const int tid = F.tid, half = tid >> 8, t256 = tid & 255, wid = (tid >> 6) & 3, lane = tid & 63, wr = wid >> 1, wc = wid & 1, fr = lane & 15, fq = lane >> 4;
    LAS unsigned char* base = F.lds + half * 32768;
    const int ntiles = TL.count();
    for (int it = 0;; ++it) {
        const int p0 = 2 * (it * F.G + F.bid);
        if (p0 >= ntiles) break;
        const int p = p0 + half; const bool valid = p < ntiles;
        STile t; TL.get(valid ? p : ntiles - 1, t);
        f32x4 acc0[4][4], acc1[4][4];
#pragma unroll
        for (int m = 0; m < 4; ++m)
#pragma unroll
            for (int n = 0; n < 4; ++n) { acc0[m][n] = (f32x4){0.f, 0.f, 0.f, 0.f}; acc1[m][n] = (f32x4){0.f, 0.f, 0.f, 0.f}; }
        for (int kt = 0; kt < K / 32; ++kt) {
#pragma unroll
            for (int i = 0; i < 2; ++i) {
                const int b = t256 * 16 + i * 4096, r = b / 64, c = (b % 64) / 2;
                const int wb = (t256 & ~63) * 16 + i * 4096;
                __builtin_amdgcn_global_load_lds((const unsigned*)(t.A + (size_t)r * K + kt * 32 + c), (LAS unsigned*)(base + wb), 16, 0, 0);
                __builtin_amdgcn_global_load_lds((const unsigned*)(t.B0 + (size_t)r * K + kt * 32 + c), (LAS unsigned*)(base + 8192 + wb), 16, 0, 0);
                if (DUAL) __builtin_amdgcn_global_load_lds((const unsigned*)(t.B1 + (size_t)r * K + kt * 32 + c), (LAS unsigned*)(base + 16384 + wb), 16, 0, 0);
            }
            asm volatile("s_waitcnt vmcnt(0)" ::: "memory"); __syncthreads();
            bf16x8 At[4], Bt0[4], Bt1[4];
#pragma unroll
            for (int m = 0; m < 4; ++m) {
                At[m] = *(const LAS bf16x8*)(base + (wr * 64 + m * 16 + fr) * 64 + fq * 16);
                Bt0[m] = *(const LAS bf16x8*)(base + 8192 + (wc * 64 + m * 16 + fr) * 64 + fq * 16);
                if (DUAL) Bt1[m] = *(const LAS bf16x8*)(base + 16384 + (wc * 64 + m * 16 + fr) * 64 + fq * 16);
            }
            asm volatile("s_waitcnt lgkmcnt(0)" ::: "memory"); __builtin_amdgcn_sched_barrier(0);
#pragma unroll
            for (int m = 0; m < 4; ++m)
#pragma unroll
                for (int n = 0; n < 4; ++n) {
                    acc0[m][n] = __builtin_amdgcn_mfma_f32_16x16x32_bf16(At[m], Bt0[n], acc0[m][n], 0, 0, 0);
                    if (DUAL) acc1[m][n] = __builtin_amdgcn_mfma_f32_16x16x32_bf16(At[m], Bt1[n], acc1[m][n], 0, 0, 0);
                }
            __syncthreads();
        }
        if (valid) {
#pragma unroll
            for (int m = 0; m < 4; ++m)
#pragma unroll
                for (int n = 0; n < 4; ++n)
#pragma unroll
                    for (int j = 0; j < 4; ++j) E(t, t.row0 + wr * 64 + m * 16 + fq * 4 + j, t.col0 + wc * 64 + n * 16 + fr, acc0[m][n][j], DUAL ? acc1[m][n][j] : 0.f);
        }
    }
}
struct DenseTiles {
    const bf16* A; const bf16* Bt; int Mr, Nc, K;
    __device__ __forceinline__ int count() const { return (Mr / 128) * (Nc / 128); }
    __device__ __forceinline__ void get(int p, STile& t) const { const int nn = Nc / 128, pm = p / nn, pn = p % nn; t.row0 = pm * 128; t.col0 = pn * 128; t.A = A + (size_t)t.row0 * K; t.B0 = Bt + (size_t)t.col0 * K; t.B1 = t.B0; t.aux = 0; }
};
struct MoeTiles {
    const bf16* A; const bf16* Bt; const int* padstart; int ncolt, K, brows; bool dualn;
    __device__ __forceinline__ int count() const { return (padstart[NE] / 128) * ncolt; }
    __device__ __forceinline__ void get(int p, STile& t) const {
        const int pm = p / ncolt, pn = p % ncolt; t.row0 = pm * 128; t.col0 = pn * 128;
        int e = 0;
#pragma unroll 1
        for (int q = 1; q < NE; ++q) if (t.row0 >= padstart[q]) e = q;
        t.aux = e; t.A = A + (size_t)t.row0 * K;
        const bf16* be = Bt + (size_t)e * brows * K;
        if (dualn) { t.B0 = be + (size_t)(pn * 256) * K; t.B1 = t.B0 + (size_t)128 * K; } else { t.B0 = be + (size_t)(pn * 128) * K; t.B1 = t.B0; }
    }
};

namespace pg8 {
#define PG8_LAS __attribute__((address_space(3)))
typedef unsigned short bf16_t;
typedef short bf16x8 __attribute__((ext_vector_type(8)));
typedef float f32x4 __attribute__((ext_vector_type(4)));
typedef unsigned u32x4 __attribute__((ext_vector_type(4)));
constexpr int BM = 256, BK = 64, HALF = 128, HTB = HALF * BK * 2  , STAGE_BYTES = 8 * HTB, NXCD = 8, WGM = 8;

__host__ __device__ __forceinline__ int lds_byte(int r, int c) { const int st = (r >> 4) * 2 + (c >> 5), rr = r & 15, cc = c & 31, ob = rr * 64 + cc * 2; return st * 1024 + (ob ^ (((ob >> 9) & 1) << 5)); }
__host__ __device__ __forceinline__ void stage_rc(int b, int& R, int& C) { const int st = b / 1024, sb = b % 1024, swz = sb ^ (((sb >> 9) & 1) << 5); R = (st >> 1) * 16 + swz / 64; C = (st & 1) * 32 + (swz % 64) / 2; }
__host__ __device__ __forceinline__ int perm32(int rho) { const int n = rho >> 4, i = rho & 15; return 8 * (i >> 2) + 4 * n + (i & 3); }

struct Unit { int pm, pn, bt, e; };
struct Gemm { const bf16_t* A; const bf16_t* Bt; int M, N, K; unsigned sa, sb; };

struct StaticOrder {
    int nM, nN, nwg, G, c;
    __host__ __device__ void init(int M, int N, int G_, int c_) { nM = M / BM; nN = N / BM; nwg = nM * nN; G = G_; c = c_; }
    __host__ __device__ bool next(int i, Unit& u) const {
        const long L = (long)i * G + c; if (L >= nwg) return false;
        int wgid = (int)L; { const int q = nwg / NXCD, r = nwg % NXCD, xcd = wgid % NXCD, off = wgid / NXCD; wgid = (xcd < r ? xcd * (q + 1) : r * (q + 1) + (xcd - r) * q) + off; }
        const int nig = WGM * nN, gid = wgid / nig, fm = gid * WGM, gsz = (nM - fm) < WGM ? (nM - fm) : WGM;
        u.pm = fm + ((wgid % nig) % gsz); u.pn = (wgid % nig) / gsz; u.bt = u.pn; u.e = 0; return true;
    }
    __device__ __forceinline__ void a_ready(const Unit&) const {}
    __device__ __forceinline__ void done(const Unit&) const {}
};

struct SkipOrder : StaticOrder {
    int t8;
    __host__ __device__ bool next(int i, Unit& u) const { if (!StaticOrder::next(i, u)) return false; if (u.pn == t8) u.pn = 45; u.bt = u.pn; return true; }
};
struct GateOrder8 : StaticOrder {
    int t8;
    __host__ __device__ bool next(int i, Unit& u) const { if (!StaticOrder::next(i, u)) return false; u.bt = u.pn; u.pn += t8; return true; }
};
__device__ __forceinline__ unsigned cvt_pk_bf16(float lo, float hi) { unsigned r; asm volatile("v_cvt_pk_bf16_f32 %0, %1, %2" : "=v"(r) : "v"(lo), "v"(hi)); return r; }
typedef float f32x2 __attribute__((ext_vector_type(2)));
typedef int v8i_t __attribute__((ext_vector_type(8)));
typedef unsigned u32x8_t __attribute__((ext_vector_type(8)));
template <class Epi, class Sched, bool ALIGN_EPI = false, bool SP2 = false, bool GATHER = false, int EB = 2>
__device__ __forceinline__ void gemm_phase(PG8_LAS unsigned char* lds, const Gemm g, const Sched& S, const Epi& E) {
    const int tid = threadIdx.x, wid = __builtin_amdgcn_readfirstlane(tid >> 6), lane = tid & 63, wr = wid >> 2, wc = wid & 3, fr = lane & 15, fq = lane >> 4;
    const int K = g.K, nt = (K * EB) / (BK * 2);
    unsigned voffA[2], voffB[2]; int RA[2]; unsigned CA2[2];
#pragma unroll
    for (int i = 0; i < 2; ++i) { int R, C; stage_rc(tid * 16 + i * 8192, R, C); const int Rb = Epi::PERM ? ((R & ~31) + perm32(R & 31)) : R;
        voffA[i] = (unsigned)(R * K * EB + C * 2); voffB[i] = (unsigned)(Rb * K * EB + C * 2); RA[i] = R; CA2[i] = (unsigned)C * 2u; }
    unsigned vo[2][2], vn[2][2];
    static_assert(!GATHER || SP2, "GATHER is written for the SP2 loop");
    const size_t kstep = (size_t)(BK * 2);
    const size_t hstep = (size_t)HALF * K * EB;
    const size_t tstep = 2 * hstep;
    const unsigned ldsw = (unsigned)wid * 1024u;
    const int ao0 = lds_byte(wr * 64 + fr, fq * 8), bo0 = lds_byte(wc * 32 + fr, fq * 8);
    constexpr int FO1 = 1024;
#define PG8_SA(b, h) (((b) * 2 + (h)) * HTB)
#define PG8_SB(b, h) ((4 + (b) * 2 + (h)) * HTB)
#define PG8_STAGE(bufoff, gbase, voff) do { _Pragma("unroll") for (int _i = 0; _i < 2; ++_i) \
        __builtin_amdgcn_global_load_lds((const unsigned*)((const char*)(gbase) + (voff)[_i]), (PG8_LAS unsigned*)(lds + (bufoff) + ldsw + _i * 8192), 16, 0, 0); } while (0)
#define PG8_STAGEA(bufoff, gbase, hf, usenext) do { if constexpr (GATHER) { unsigned vs_[2] = {(usenext) ? vn[hf][0] : vo[hf][0], (usenext) ? vn[hf][1] : vo[hf][1]}; PG8_STAGE(bufoff, gbase, vs_); } else PG8_STAGE(bufoff, (gbase) + (hf) * hstep, voffA); } while (0)
#define PG8_LDA(dst, b, h) do { _Pragma("unroll") for (int m = 0; m < 4; ++m) { if constexpr (EB == 2) { dst[m][0] = *(const PG8_LAS bf16x8*)(lds + PG8_SA(b, h) + ao0 + m * 2048); dst[m][1] = *(const PG8_LAS bf16x8*)(lds + PG8_SA(b, h) + ao0 + FO1 + m * 2048); } \
        else dst##8[m] = __builtin_shufflevector(*(const PG8_LAS u32x4*)(lds + PG8_SA(b, h) + ao0 + m * 2048), *(const PG8_LAS u32x4*)(lds + PG8_SA(b, h) + ao0 + FO1 + m * 2048), 0, 1, 2, 3, 4, 5, 6, 7); } } while (0)
#define PG8_LDB(dst, b, h) do { _Pragma("unroll") for (int n = 0; n < 2; ++n) { if constexpr (EB == 2) { dst[n][0] = *(const PG8_LAS bf16x8*)(lds + PG8_SB(b, h) + bo0 + n * 2048); dst[n][1] = *(const PG8_LAS bf16x8*)(lds + PG8_SB(b, h) + bo0 + FO1 + n * 2048); } \
        else dst##8[n] = __builtin_shufflevector(*(const PG8_LAS u32x4*)(lds + PG8_SB(b, h) + bo0 + n * 2048), *(const PG8_LAS u32x4*)(lds + PG8_SB(b, h) + bo0 + FO1 + n * 2048), 0, 1, 2, 3, 4, 5, 6, 7); } } while (0)
#define PG8_MMA(ai, bj, At, Bt) do { __builtin_amdgcn_s_setprio(1); if constexpr (EB == 2) { _Pragma("unroll") for (int m = 0; m < 4; ++m) _Pragma("unroll") for (int n = 0; n < 2; ++n) _Pragma("unroll") for (int k = 0; k < 2; ++k) \
        acc[ai][bj][m][n] = __builtin_amdgcn_mfma_f32_16x16x32_bf16(Bt[n][k], At[m][k], acc[ai][bj][m][n], 0, 0, 0); } else { asm volatile("s_nop 1"); _Pragma("unroll") for (int m = 0; m < 4; ++m) _Pragma("unroll") for (int n = 0; n < 2; ++n) \
        asm volatile("v_mfma_scale_f32_16x16x128_f8f6f4 %0, %1, %2, %0, %3, %4 op_sel_hi:[0,0,0]" : "+v"(acc[ai][bj][m][n]) : "v"(Bt##8[n]), "v"(At##8[m]), "v"(vsb), "v"(vsa)); } __builtin_amdgcn_s_setprio(0); } while (0)
#define PG8_WAIT_V(n) asm volatile("s_waitcnt vmcnt(" #n ")" ::: "memory")
#define PG8_WAIT_L(n) asm volatile("s_waitcnt lgkmcnt(" #n ")" ::: "memory")
#define PG8_BAR __builtin_amdgcn_s_barrier()
#define PG8_SCHED __builtin_amdgcn_sched_barrier(0)
    Unit cur, nxt; int ui = 0;
    if (!S.next(0, cur)) return;
    f32x4 acc[2][2][4][2];
#pragma unroll
    for (int a = 0; a < 2; ++a)
#pragma unroll
        for (int b = 0; b < 2; ++b)
#pragma unroll
            for (int m = 0; m < 4; ++m)
#pragma unroll
                for (int n = 0; n < 2; ++n) acc[a][b][m][n] = (f32x4){0.f, 0.f, 0.f, 0.f};
    unsigned vsa = g.sa, vsb = g.sb; if constexpr (EB == 1) asm volatile("" : "+v"(vsa), "+v"(vsb));
    bf16x8 At[4][2], B0[2][2], B1[2][2]; u32x8_t At8[4], B08[2], B18[2];
    const char* cA = GATHER ? (const char*)g.A : (const char*)g.A + (size_t)cur.pm * tstep; const char* cB = (const char*)g.Bt + (size_t)cur.bt * tstep;
    if constexpr (GATHER) {
#pragma unroll
        for (int hf = 0; hf < 2; ++hf)
#pragma unroll
            for (int i = 0; i < 2; ++i) { vo[hf][i] = S.gtab[hf * HALF + RA[i]] + CA2[i]; vn[hf][i] = vo[hf][i]; } }
    S.a_ready(cur);
    if constexpr (SP2) {
        PG8_STAGE(PG8_SB(0, 0), cB, voffB); PG8_STAGE(PG8_SB(0, 1), cB + hstep, voffB); PG8_STAGEA(PG8_SA(0, 0), cA, 0, false); PG8_STAGEA(PG8_SA(0, 1), cA, 1, false);
        if (wr == 1) PG8_BAR;
        PG8_WAIT_V(2); PG8_BAR;
        PG8_STAGE(PG8_SB(1, 0), cB + kstep, voffB); PG8_STAGEA(PG8_SA(1, 0), cA + kstep, 0, false); PG8_STAGE(PG8_SB(1, 1), cB + hstep + kstep, voffB);
        PG8_WAIT_V(6); PG8_BAR;
    } else {
        PG8_STAGE(PG8_SB(0, 0), cB, voffB); PG8_STAGE(PG8_SA(0, 0), cA, voffA); PG8_STAGE(PG8_SB(0, 1), cB + hstep, voffB); PG8_STAGE(PG8_SA(0, 1), cA + hstep, voffA);
        if (wr == 1) PG8_BAR;
        PG8_WAIT_V(4); PG8_BAR;
        PG8_STAGE(PG8_SB(1, 0), cB + kstep, voffB); PG8_STAGE(PG8_SA(1, 0), cA + kstep, voffA); PG8_STAGE(PG8_SB(1, 1), cB + hstep + kstep, voffB);
        PG8_WAIT_V(6); PG8_BAR;
    }
    for (;;) {
        const bool has_next = S.next(ui + 1, nxt);
        const char* nA = (has_next && !GATHER) ? (const char*)g.A + (size_t)nxt.pm * tstep : cA;
        if constexpr (GATHER) {
#pragma unroll
            for (int hf = 0; hf < 2; ++hf)
#pragma unroll
                for (int i = 0; i < 2; ++i) vn[hf][i] = has_next ? S.gtab[(ui + 1) * BM + hf * HALF + RA[i]] + CA2[i] : vo[hf][i]; } const char* nB = has_next ? (const char*)g.Bt + (size_t)nxt.bt * tstep : cB;
        for (int t = 0; t < nt; t += 2) {
            const bool last = (t == nt - 2);
            const char* a1 = cA + (size_t)(t + 1) * kstep;
            const char* a2 = last ? nA : cA + (size_t)(t + 2) * kstep; const char* b2 = last ? nB : cB + (size_t)(t + 2) * kstep;
            const char* a3 = a2 + kstep; const char* b3 = b2 + kstep;
            if (last && has_next) S.a_ready(nxt);
            if constexpr (SP2) {
            PG8_LDB(B0, 0, 0); PG8_LDB(B1, 0, 1); PG8_SCHED; PG8_LDA(At, 0, 0); PG8_STAGEA(PG8_SA(1, 1), a1, 1, false);
            PG8_WAIT_V(8); PG8_WAIT_L(0); PG8_BAR; PG8_MMA(0, 0, At, B0); PG8_MMA(0, 1, At, B1); PG8_BAR; PG8_SCHED;
            PG8_LDA(At, 0, 1); PG8_STAGE(PG8_SB(0, 0), b2, voffB); PG8_STAGE(PG8_SB(0, 1), b2 + hstep, voffB); PG8_STAGEA(PG8_SA(0, 0), a2, 0, last);
            PG8_WAIT_V(8); PG8_WAIT_L(0); PG8_BAR; PG8_MMA(1, 0, At, B0); PG8_MMA(1, 1, At, B1); PG8_BAR; PG8_SCHED;
            PG8_LDB(B0, 1, 0); PG8_LDB(B1, 1, 1); PG8_SCHED; PG8_LDA(At, 1, 0); PG8_STAGEA(PG8_SA(0, 1), a2, 1, last);
            PG8_WAIT_V(8); PG8_WAIT_L(0); PG8_BAR; PG8_MMA(0, 0, At, B0); PG8_MMA(0, 1, At, B1); PG8_BAR; PG8_SCHED;
            PG8_LDA(At, 1, 1); PG8_STAGE(PG8_SB(1, 0), b3, voffB); PG8_STAGE(PG8_SB(1, 1), b3 + hstep, voffB); PG8_STAGEA(PG8_SA(1, 0), a3, 0, last);
            PG8_WAIT_V(8); PG8_WAIT_L(0); PG8_BAR; PG8_MMA(1, 0, At, B0); PG8_MMA(1, 1, At, B1); PG8_BAR; PG8_SCHED;
            } else {
            PG8_LDB(B0, 0, 0); PG8_SCHED; PG8_LDA(At, 0, 0); PG8_STAGE(PG8_SA(1, 1), a1 + hstep, voffA);
            PG8_WAIT_L(8); PG8_BAR; PG8_WAIT_L(0); PG8_MMA(0, 0, At, B0); PG8_BAR; PG8_SCHED;
            PG8_LDB(B1, 0, 1); PG8_STAGE(PG8_SB(0, 0), b2, voffB);
            PG8_BAR; PG8_WAIT_L(0); PG8_MMA(0, 1, At, B1); PG8_BAR;
            PG8_LDA(At, 0, 1); PG8_STAGE(PG8_SA(0, 0), a2, voffA);
            PG8_BAR; PG8_WAIT_L(0); PG8_MMA(1, 0, At, B0); PG8_BAR; PG8_SCHED;
            PG8_STAGE(PG8_SB(0, 1), b2 + hstep, voffB);
            PG8_WAIT_V(6); PG8_BAR; PG8_MMA(1, 1, At, B1); PG8_BAR;
            PG8_LDB(B0, 1, 0); PG8_SCHED; PG8_LDA(At, 1, 0); PG8_STAGE(PG8_SA(0, 1), a2 + hstep, voffA);
            PG8_WAIT_L(8); PG8_BAR; PG8_WAIT_L(0); PG8_MMA(0, 0, At, B0); PG8_BAR; PG8_SCHED;
            PG8_LDB(B1, 1, 1); PG8_STAGE(PG8_SB(1, 0), b3, voffB);
            PG8_BAR; PG8_WAIT_L(0); PG8_MMA(0, 1, At, B1); PG8_BAR;
            PG8_LDA(At, 1, 1); PG8_STAGE(PG8_SA(1, 0), a3, voffA);
            PG8_BAR; PG8_WAIT_L(0); PG8_MMA(1, 0, At, B0); PG8_BAR; PG8_SCHED;
            PG8_STAGE(PG8_SB(1, 1), b3 + hstep, voffB);
            PG8_WAIT_V(6); PG8_BAR; PG8_MMA(1, 1, At, B1); PG8_BAR;
            }
        }
        if constexpr (EB == 1) {
            asm volatile("s_nop 15\n\ts_nop 15" ::: "memory");
#pragma unroll
            for (int a_ = 0; a_ < 2; ++a_)
#pragma unroll
                for (int b_ = 0; b_ < 2; ++b_)
#pragma unroll
                    for (int m_ = 0; m_ < 4; ++m_) asm volatile("" : "+v"(acc[a_][b_][m_][0]), "+v"(acc[a_][b_][m_][1]));
        }
        if constexpr (ALIGN_EPI) { if (wr == 0) PG8_BAR; }
        if constexpr (!Epi::AFTER_DRAIN) { E(acc, cur, wr, wc, fr, fq); S.done(cur); }
        if (!has_next) break;
#pragma unroll
        for (int a = 0; a < 2; ++a)
#pragma unroll
            for (int b = 0; b < 2; ++b)
#pragma unroll
                for (int m = 0; m < 4; ++m)
#pragma unroll
                    for (int n = 0; n < 2; ++n) acc[a][b][m][n] = (f32x4){0.f, 0.f, 0.f, 0.f};
        cur = nxt; cA = nA; cB = nB; ++ui;
        if constexpr (GATHER) {
#pragma unroll
            for (int hf = 0; hf < 2; ++hf)
#pragma unroll
                for (int i = 0; i < 2; ++i) vo[hf][i] = vn[hf][i]; }
        if constexpr (ALIGN_EPI) { if (wr == 1) PG8_BAR; }
    }
    PG8_WAIT_V(0);
    if constexpr (!ALIGN_EPI) { if (wr == 0) PG8_BAR; }
    PG8_BAR;
    if constexpr (Epi::AFTER_DRAIN) { E.fused(acc, cur, wr, wc, fr, fq, lds, wid, lane); S.done(cur); }
#undef PG8_SA
#undef PG8_SB
#undef PG8_STAGE
#undef PG8_STAGEA
#undef PG8_LDA
#undef PG8_LDB
#undef PG8_MMA
#undef PG8_WAIT_V
#undef PG8_WAIT_L
#undef PG8_BAR
#undef PG8_SCHED
}
}

namespace pg8 {
__device__ __forceinline__ u32x4 pack8(f32x4 v0, f32x4 v1) { u32x4 w; w.x = cvt_pk_bf16(v0[0], v0[1]); w.y = cvt_pk_bf16(v0[2], v0[3]); w.z = cvt_pk_bf16(v1[0], v1[1]); w.w = cvt_pk_bf16(v1[2], v1[3]); return w; }
__device__ __forceinline__ void unpack8(u32x4 w, f32x4& v0, f32x4& v1) { v0 = (f32x4){bflo(w.x), bfhi(w.x), bflo(w.y), bfhi(w.y)}; v1 = (f32x4){bflo(w.z), bfhi(w.z), bflo(w.w), bfhi(w.w)}; }
__device__ __forceinline__ f32x4 sig4(f32x4 v) { return (f32x4){sigmoidf_(v[0]), sigmoidf_(v[1]), sigmoidf_(v[2]), sigmoidf_(v[3])}; }
__device__ __forceinline__ f32x4 silu4(f32x4 v) { return (f32x4){siluf_(v[0]), siluf_(v[1]), siluf_(v[2]), siluf_(v[3])}; }
struct EpiProjF { static constexpr bool PERM = true, AFTER_DRAIN = false; bf16_t* proj; float* alr; bf16_t* qaf; bf16_t* kaf; bf16_t* vaf; bf16_t* vgt;
    __device__ __forceinline__ void operator()(const f32x4 (&acc)[2][2][4][2], const Unit& u, int wr, int wc, int fr, int fq) const {
        const int row0 = u.pm * BM + wr * 64 + fr, colt = u.pn * BM;
        if (colt >= PJ) {
            if (wc == 0 && fq < 2) {
#pragma unroll
                for (int ai = 0; ai < 2; ++ai)
#pragma unroll
                    for (int m = 0; m < 4; ++m) { float* p = alr + (size_t)(row0 + ai * HALF + m * 16) * GR + 8 * fq; *(f32x4*)p = acc[ai][0][m][0]; *(f32x4*)(p + 4) = acc[ai][0][m][1]; }
            }
            return;
        }
        if (colt < C_QG) {
            const int sfr = (wc & 1) * 2 + (fq >> 1), hfr = fq & 1;
#pragma unroll
            for (int ai = 0; ai < 2; ++ai)
#pragma unroll
                for (int m = 0; m < 4; ++m) { const int r = row0 + ai * HALF + m * 16, b = r / T, ts = r % T, qt = ts >> 5, nt = ts & 31;
#pragma unroll
                    for (int bj = 0; bj < 2; ++bj) {
                        if (colt < C_KA) { const int hq = colt / 64 + bj * 2 + (wc >> 1);
                            *(u32x4*)(qaf + (((((size_t)(b * AH + hq) * (T / 32) + qt) * 4 + sfr) * 64 + hfr * 32 + nt) << 3)) = pack8(acc[ai][bj][m][0], acc[ai][bj][m][1]); }
                        else if (bj == 0) { const int kh = wc >> 1;
                            *(u32x4*)(kaf + (((((size_t)(b * AKV + kh) * (T / 32) + qt) * 4 + sfr) * 64 + hfr * 32 + nt) << 3)) = pack8(acc[ai][0][m][0], acc[ai][0][m][1]); }
                        else { const int kh = wc >> 1, s2 = nt >> 4, r16 = nt & 15, jj = 4 * (r16 >> 3) + (r16 & 3), hh = (r16 >> 2) & 1;
                            bf16_t* vp = vaf + ((((((size_t)(b * AKV + kh) * (T / 32) + qt) * 2 + (wc & 1)) * 2 + s2) * 64 + hh * 32 + 8 * fq) << 3) + jj;
#pragma unroll
                            for (int n = 0; n < 2; ++n)
#pragma unroll
                                for (int j = 0; j < 4; ++j) vp[(4 * n + j) * 8] = (bf16_t)f2bf(acc[ai][1][m][n][j]); }
                    } }
            return;
        }
        const int act = colt >= C_GA ? 2 : (colt >= C_RG ? 1 : 0);
        const int col0 = colt + wc * 32 + 8 * fq;
        if (colt >= C_VG && colt < C_RG) {
            const int hd = (colt - C_VG) / GHV, sl0 = ((colt - C_VG) % GHV) / 32 + wc;
#pragma unroll
            for (int ai = 0; ai < 2; ++ai)
#pragma unroll
                for (int m = 0; m < 4; ++m) { const int r = row0 + ai * HALF + m * 16, b = r / T, ts = r % T, t = ts & 63; const int uu = (b * GH + hd) * GNC + (ts >> 6);
#pragma unroll
                    for (int bj = 0; bj < 2; ++bj) { bf16_t* vp = vgt + ((((size_t)uu * 16 + sl0 + 4 * bj) * 4 + (t >> 4)) * 64 + ((t >> 3) & 1) * 32 + 8 * fq) * 8 + (t & 7);
#pragma unroll
                        for (int n = 0; n < 2; ++n)
#pragma unroll
                            for (int j = 0; j < 4; ++j) vp[(4 * n + j) * 8] = (bf16_t)f2bf(acc[ai][bj][m][n][j]); } }
#if FAST & 128
            return;
#endif
        }
#pragma unroll
        for (int ai = 0; ai < 2; ++ai)
#pragma unroll
            for (int m = 0; m < 4; ++m) { bf16_t* rowp = proj + (size_t)(row0 + ai * HALF + m * 16) * PJ + col0;
#pragma unroll
                for (int bj = 0; bj < 2; ++bj) { f32x4 v0 = acc[ai][bj][m][0], v1 = acc[ai][bj][m][1];
                    if (act == 1) { v0 = silu4(v0); v1 = silu4(v1); } else if (act == 2) { v0 = sig4(v0); v1 = sig4(v1); }
                    *(u32x4*)(rowp + bj * HALF) = pack8(v0, v1); } }
    }
};
struct EpiT1F { static constexpr bool PERM = true, AFTER_DRAIN = false; const bf16_t* proj; bf16_t* t1;
    __device__ __forceinline__ void operator()(const f32x4 (&acc)[2][2][4][2], const Unit& u, int wr, int wc, int fr, int fq) const {
        const int row0 = u.pm * BM + wr * 64 + fr, col0 = u.pn * BM + wc * 32 + 8 * fq;
#pragma unroll
        for (int ai = 0; ai < 2; ++ai)
#pragma unroll
            for (int m = 0; m < 4; ++m) { const size_t row = (size_t)(row0 + ai * HALF + m * 16);
#pragma unroll
                for (int bj = 0; bj < 2; ++bj) { f32x4 g0, g1; unpack8(*(const u32x4*)(proj + row * PJ + C_GA + col0 + bj * HALF), g0, g1);
                    *(u32x4*)(t1 + row * D + col0 + bj * HALF) = pack8(acc[ai][bj][m][0] * g0, acc[ai][bj][m][1] * g1); } }
    }
};
struct EpiMergedF { static constexpr bool PERM = true, AFTER_DRAIN = false; const bf16_t* proj; const bf16_t* t1; bf16_t* mg;
    __device__ __forceinline__ void operator()(const f32x4 (&acc)[2][2][4][2], const Unit& u, int wr, int wc, int fr, int fq) const {
        const int row0 = u.pm * BM + wr * 64 + fr, col0 = u.pn * BM + wc * 32 + 8 * fq;
#pragma unroll
        for (int ai = 0; ai < 2; ++ai)
#pragma unroll
            for (int m = 0; m < 4; ++m) { const size_t row = (size_t)(row0 + ai * HALF + m * 16);
#pragma unroll
                for (int bj = 0; bj < 2; ++bj) { f32x4 g0, g1; unpack8(*(const u32x4*)(proj + row * PJ + C_GG + col0 + bj * HALF), g0, g1);
                    f32x4 a0, a1; unpack8(*(const u32x4*)(t1 + row * D + col0 + bj * HALF), a0, a1);
                    const f32x4 r0 = a0 + acc[ai][bj][m][0] * g0, r1 = a1 + acc[ai][bj][m][1] * g1;
#if FP8WO
                    v2u w; w.x = pk4_fp8(16.f * r0[0], 16.f * r0[1], 16.f * r0[2], 16.f * r0[3]); w.y = pk4_fp8(16.f * r1[0], 16.f * r1[1], 16.f * r1[2], 16.f * r1[3]);
                    *(v2u*)((unsigned char*)mg + row * D + col0 + bj * HALF) = w; } }
#else
                    *(u32x4*)(mg + row * D + col0 + bj * HALF) = pack8(r0, r1); } }
#endif
    }
};
struct EpiUF { static constexpr bool PERM = true, AFTER_DRAIN = false; const float* ada; bf16_t* mixg;
    __device__ __forceinline__ void operator()(const f32x4 (&acc)[2][2][4][2], const Unit& u, int wr, int wc, int fr, int fq) const {
        const int row0 = u.pm * BM + wr * 64 + fr, col0 = u.pn * BM + wc * 32 + 8 * fq; const float* gt = ada + ((u.pm * BM) / T) * 6 * D + 2 * D;
#pragma unroll
        for (int bj = 0; bj < 2; ++bj) { const f32x4 g0 = *(const f32x4*)(gt + col0 + bj * HALF), g1 = *(const f32x4*)(gt + col0 + bj * HALF + 4);
#pragma unroll
            for (int ai = 0; ai < 2; ++ai)
#pragma unroll
                for (int m = 0; m < 4; ++m) *(u32x4*)(mixg + (size_t)(row0 + ai * HALF + m * 16) * D + col0 + bj * HALF) = pack8(g0 * acc[ai][bj][m][0], g1 * acc[ai][bj][m][1]); }
    }
};
struct EpiSwigluF { static constexpr bool PERM = true, AFTER_DRAIN = false; const float* bgu; bf16_t* act;
    __device__ __forceinline__ void operator()(const f32x4 (&acc)[2][2][4][2], const Unit& u, int wr, int wc, int fr, int fq) const {
        const int row0 = u.pm * BM + wr * 64 + fr, c0 = u.pn * HALF + wc * 32 + 8 * fq;
        const float* be = bgu + (size_t)u.e * 2 * FF + 2 * c0;
        const f32x4 f0 = *(const f32x4*)be, f1 = *(const f32x4*)(be + 4), f2 = *(const f32x4*)(be + 8), f3 = *(const f32x4*)(be + 12);
        const f32x4 bg0 = (f32x4){f0.x, f0.z, f1.x, f1.z}, bu0 = (f32x4){f0.y, f0.w, f1.y, f1.w}, bg1 = (f32x4){f2.x, f2.z, f3.x, f3.z}, bu1 = (f32x4){f2.y, f2.w, f3.y, f3.w};
#pragma unroll
        for (int ai = 0; ai < 2; ++ai)
#pragma unroll
            for (int m = 0; m < 4; ++m) { f32x4 r[2];
#pragma unroll
                for (int n = 0; n < 2; ++n) { const f32x4 g = acc[ai][0][m][n] + (n ? bg1 : bg0), up = acc[ai][1][m][n] + (n ? bu1 : bu0);
#pragma unroll
                    for (int j = 0; j < 4; ++j) { const float gg = fminf(g[j], 7.f), uu = fminf(fmaxf(up[j], -7.f), 7.f); r[n][j] = (uu + 1.f) * gg * __builtin_amdgcn_rcpf(1.f + __builtin_amdgcn_exp2f(-2.4554669595930157f * gg)); } }
                *(u32x4*)(act + (size_t)(row0 + ai * HALF + m * 16) * FF + c0) = pack8(r[0], r[1]); }
    }
};
struct EpiSwiglu8 { static constexpr bool PERM = true, AFTER_DRAIN = false; const float* bgu; unsigned char* act;
    __device__ __forceinline__ void operator()(const f32x4 (&acc)[2][2][4][2], const Unit& u, int wr, int wc, int fr, int fq) const {
        const int row0 = u.pm * BM + wr * 64 + fr, c0 = u.pn * HALF + wc * 32 + 8 * fq;
        const float* be = bgu + (size_t)u.e * 2 * FF + 2 * c0;
        const f32x4 f0 = *(const f32x4*)be, f1 = *(const f32x4*)(be + 4), f2 = *(const f32x4*)(be + 8), f3 = *(const f32x4*)(be + 12);
        const f32x4 bg0 = (f32x4){f0.x, f0.z, f1.x, f1.z}, bu0 = (f32x4){f0.y, f0.w, f1.y, f1.w}, bg1 = (f32x4){f2.x, f2.z, f3.x, f3.z}, bu1 = (f32x4){f2.y, f2.w, f3.y, f3.w};
#pragma unroll
        for (int ai = 0; ai < 2; ++ai)
#pragma unroll
            for (int m = 0; m < 4; ++m) { f32x4 r[2];
#pragma unroll
                for (int n = 0; n < 2; ++n) { const f32x4 g = acc[ai][0][m][n] + (n ? bg1 : bg0), up = acc[ai][1][m][n] + (n ? bu1 : bu0);
#pragma unroll
                    for (int j = 0; j < 4; ++j) { const float gg = fminf(g[j], 7.f), uu = fminf(fmaxf(up[j], -7.f), 7.f); r[n][j] = 4.f * (uu + 1.f) * gg * __builtin_amdgcn_rcpf(1.f + __builtin_amdgcn_exp2f(-2.4554669595930157f * gg)); } }
                v2u w; w.x = pk4_fp8(r[0][0], r[0][1], r[0][2], r[0][3]); w.y = pk4_fp8(r[1][0], r[1][1], r[1][2], r[1][3]);
                *(v2u*)(act + (size_t)(row0 + ai * HALF + m * 16) * FF + c0) = w; }
    }
};
struct EpiDownF { static constexpr bool PERM = true, AFTER_DRAIN = false; const float* bd; const float* roww; bf16_t* ys;
    __device__ __forceinline__ void operator()(const f32x4 (&acc)[2][2][4][2], const Unit& u, int wr, int wc, int fr, int fq) const {
        const int row0 = u.pm * BM + wr * 64 + fr, col0 = u.pn * BM + wc * 32 + 8 * fq; const float* be = bd + (size_t)u.e * D + col0;
        f32x4 b[2][2];
#pragma unroll
        for (int bj = 0; bj < 2; ++bj) { b[bj][0] = *(const f32x4*)(be + bj * HALF); b[bj][1] = *(const f32x4*)(be + bj * HALF + 4); }
#pragma unroll
        for (int ai = 0; ai < 2; ++ai)
#pragma unroll
            for (int m = 0; m < 4; ++m) { const size_t row = (size_t)(row0 + ai * HALF + m * 16); const float w = roww[row];
#pragma unroll
                for (int bj = 0; bj < 2; ++bj) {
#if YS8
                    const f32x4 r0 = (acc[ai][bj][m][0] + b[bj][0]) * (16.f * w), r1 = (acc[ai][bj][m][1] + b[bj][1]) * (16.f * w);
                    v2u w8; w8.x = pk4_fp8(r0[0], r0[1], r0[2], r0[3]); w8.y = pk4_fp8(r1[0], r1[1], r1[2], r1[3]);
                    *(v2u*)((unsigned char*)ys + row * D + col0 + bj * HALF) = w8; }
#else
                    *(u32x4*)(ys + row * D + col0 + bj * HALF) = pack8((acc[ai][bj][m][0] + b[bj][0]) * w, (acc[ai][bj][m][1] + b[bj][1]) * w); }
#endif
            }
    }
};
struct MoeOrder : StaticOrder {
    int NT; const PG8_LAS unsigned char* t2e; const PG8_LAS unsigned* gtab;
    __device__ __forceinline__ bool next(int i, Unit& u) const { if (!StaticOrder::next(i, u)) return false; u.e = __builtin_amdgcn_readfirstlane((int)t2e[u.pm]); u.bt = u.e * NT + u.pn; return true; }
};
}

template <class RowMap>
__device__ __forceinline__ void transpose_item(const float* W, int K, int N, bf16* WT, LAS float* scr, int kb, int nb, int lane, const RowMap& rm) {
    const int k0 = 64 * kb, n0 = 32 * nb;
    const int nsrc = n0 + (lane & 31);
#pragma unroll 8
    for (int i = 0; i < 32; ++i) { const int kk = 2 * i + (lane >> 5); scr[kk * 33 + (lane & 31)] = (nsrc < N) ? W[(size_t)(k0 + kk) * N + nsrc] : 0.f; }
    LDS_WAIT(); asm volatile("" ::: "memory");
    const int c = lane & 7;
#pragma unroll
    for (int j = 0; j < 4; ++j) { const int n = (lane >> 3) + 8 * j; const LAS float* s = scr + (8 * c) * 33 + n;
        v4u o; o.x = pk2(s[0 * 33], s[1 * 33]); o.y = pk2(s[2 * 33], s[3 * 33]); o.z = pk2(s[4 * 33], s[5 * 33]); o.w = pk2(s[6 * 33], s[7 * 33]);
        if (n0 + n < N) *(GAS v4u*)(WT + (size_t)rm(n0 + n) * K + k0 + 8 * c) = o; }
    LDS_WAIT(); asm volatile("" ::: "memory");
}
struct RmIdent { __device__ __forceinline__ int operator()(int n) const { return n; } };
#if FP8GATE
struct RmWin { __device__ __forceinline__ int operator()(int n) const { return n < C8_LO ? n : (n >= SRC_ALR && n < SRC_ALR + GR ? PJ + (n - SRC_ALR) : -1); } };
#else
struct RmWin { __device__ __forceinline__ int operator()(int n) const { return n < SRC_ALR ? n : (n < SRC_ALR + GR ? PJ + (n - SRC_ALR) : n - GR); } };
#endif
struct RmGateUp { __device__ __forceinline__ int operator()(int n) const { const int j = n >> 1, up = n & 1; return (j >> 7) * 256 + up * 128 + (j & 127); } };

template <class RowMap>
__device__ __forceinline__ void transpose_item2(const float* W, int K, int N, bf16* WT, LAS unsigned* scr, int kb2, int nb, int lane, const RowMap& rm) {
    const int n0 = 128 * nb, hh = lane >> 5, n4 = (lane & 31) * 4; const bool ok = n0 + n4 < N;
#pragma unroll 1
    for (int sub = 0; sub < 2; ++sub) {
        const int k0 = 64 * kb2 + 32 * sub;
        f32x4 v[16];
        const float* wp = W + (size_t)(k0 + 16 * hh) * N + n0 + n4;
#pragma unroll
        for (int i = 0; i < 16; ++i) v[i] = ok ? *(const GAS f32x4*)(wp + (size_t)i * N) : (f32x4){0.f, 0.f, 0.f, 0.f};
#pragma unroll
        for (int ip = 0; ip < 8; ++ip)
#pragma unroll
            for (int c = 0; c < 4; ++c) scr[(n4 + c) * 17 + 8 * hh + ip] = pk2(v[2 * ip][c], v[2 * ip + 1][c]);
        LDS_WAIT(); asm volatile("" ::: "memory");
#pragma unroll
        for (int j = 0; j < 8; ++j) { const int n = (lane >> 2) + 16 * j, q = lane & 3; const LAS unsigned* sp = scr + n * 17 + 4 * q;
            const v4u o = (v4u){sp[0], sp[1], sp[2], sp[3]};
            const int drow = (n0 + n < N) ? rm(n0 + n) : -1;
            if (drow >= 0) *(GAS v4u*)(WT + (size_t)drow * K + k0 + 8 * q) = o; }
        LDS_WAIT(); asm volatile("" ::: "memory");
    }
}
struct SubT { const float* src; bf16* dst; int N, n0, gu; };
__device__ __forceinline__ SubT moe_subtile(const Args& a, unsigned char* ws, int it) {
    constexpr int I_GU = 32 * 64, I_DN = 32 * 32;
    SubT t;
    if (it < NE * I_GU) { const int e = it / I_GU, r = it % I_GU, kb = ITEM_NBFAST ? 2 * ((r >> 1) / 64) + (r & 1) : r % 32, nb = ITEM_NBFAST ? (r >> 1) % 64 : r / 32, k0 = 64 * kb; t.N = 2 * FF; t.n0 = 64 * nb; t.gu = 1;
        t.src = a.w_gate_up + (size_t)e * D * 2 * FF + (size_t)k0 * (2 * FF) + t.n0;
        t.dst = FP8MOE ? (bf16*)(ws + WS_WGU8 + (size_t)e * 2 * FF * D + k0) : (bf16*)(ws + WS_WGUT) + (size_t)e * 2 * FF * D + k0; }
    else { const int i2 = it - NE * I_GU, e = i2 / I_DN, r = i2 % I_DN, kb = ITEM_NBFAST ? 2 * ((r >> 1) / 32) + (r & 1) : r % 32, nb = ITEM_NBFAST ? (r >> 1) % 32 : r / 32, k0 = 64 * kb; t.N = D; t.n0 = 64 * nb; t.gu = 0;
        t.src = a.w_down + (size_t)e * FF * D + (size_t)k0 * D + t.n0;
        t.dst = FP8MOE ? (bf16*)(ws + WS_WDN8 + (size_t)e * D * FF + k0) : (bf16*)(ws + WS_WDNT) + (size_t)e * D * FF + k0; }
    return t;
}
__device__ __forceinline__ void subt_load(const SubT& t, int lane, f32x4 (&v)[16]) {
    const float* wp = t.src + (size_t)(16 * (lane >> 4)) * t.N + (lane & 15) * 4;
#pragma unroll
    for (int i = 0; i < 16; ++i) v[i] = __builtin_nontemporal_load((const f32x4*)(wp + (size_t)i * t.N));
}
__device__ __forceinline__ void subt_store(const SubT& t, int lane, const f32x4 (&v)[16], LAS unsigned* scr) {
    const int g = lane >> 4, n4 = (lane & 15) * 4;
#pragma unroll
    for (int ip = 0; ip < 8; ++ip)
#pragma unroll
        for (int c = 0; c < 4; ++c) scr[(n4 + c) * 33 + 8 * g + ip] = pk2(v[2 * ip][c], v[2 * ip + 1][c]);
    LDS_WAIT(); asm volatile("" ::: "memory");
#pragma unroll
    for (int j = 0; j < 8; ++j) { const int n = (lane >> 3) + 8 * j, q = lane & 7, ng = t.n0 + n; const LAS unsigned* sp = scr + n * 33 + 4 * q;
        const v4u o = (v4u){sp[0], sp[1], sp[2], sp[3]};
        const int row = t.gu ? ((ng >> 8) * 256 + (ng & 1) * 128 + ((ng >> 1) & 127)) : ng;
        __builtin_nontemporal_store(o, (v4u*)(t.dst + (size_t)row * D + 8 * q)); }
    LDS_WAIT(); asm volatile("" ::: "memory");
}
#if FP8MOE
__device__ __forceinline__ void subt_store8(const SubT& t, int lane, const f32x4 (&v)[16], LAS unsigned* scr, int pitch = D) {
    const int g = lane >> 4, n4 = (lane & 15) * 4;
#pragma unroll
    for (int p = 0; p < 4; ++p)
#pragma unroll
        for (int c = 0; c < 4; ++c) scr[(n4 + c) * 17 + 4 * g + p] = pk4_fp8(v[4 * p][c] * 64.f, v[4 * p + 1][c] * 64.f, v[4 * p + 2][c] * 64.f, v[4 * p + 3][c] * 64.f);
    LDS_WAIT(); asm volatile("" ::: "memory");
#pragma unroll
    for (int j = 0; j < 4; ++j) { const int n = (lane >> 2) + 16 * j, q = lane & 3, ng = t.n0 + n; const LAS unsigned* sp = scr + n * 17 + 4 * q;
        const v4u o = (v4u){sp[0], sp[1], sp[2], sp[3]};
        const int row = t.gu ? ((ng >> 8) * 256 + (ng & 1) * 128 + ((ng >> 1) & 127)) : ng;
        *(GAS v4u*)((unsigned char*)t.dst + (size_t)row * pitch + 16 * q) = o; }
    LDS_WAIT(); asm volatile("" ::: "memory");
}
#endif
__device__ __forceinline__ void phase_prologue(const Frame& F, const Args& a) {
    unsigned char* ws = a.ws;
    {
        LAS float* sc = (LAS float*)(F.lds);
        LAS float* part = (LAS float*)(F.lds + 32768);
        for (int i = F.tid; i < NB * D; i += 512) sc[i] = siluf_(a.c[i]);
        __syncthreads();
        float* ada = (float*)(ws + WS_ADA);
        for (int u = F.bid; u < 6 * D / 64; u += F.G) {
            const int j = u * 64 + F.lane;
            float acc[4] = {0.f, 0.f, 0.f, 0.f};
            const float* wp = a.w_ada + (size_t)(F.wave * 256) * (6 * D) + j;
#pragma unroll 16
            for (int k = 0; k < 256; ++k) { const float w = wp[(size_t)k * (6 * D)]; const int kk = F.wave * 256 + k;
                acc[0] += sc[kk] * w; acc[1] += sc[D + kk] * w; acc[2] += sc[2 * D + kk] * w; acc[3] += sc[3 * D + kk] * w; }
#pragma unroll
            for (int b = 0; b < 4; ++b) part[(F.wave * 4 + b) * 64 + F.lane] = acc[b];
            __syncthreads();
            if (F.wave < 4) { float s = a.b_ada[j];
#pragma unroll
                for (int w = 0; w < 8; ++w) s += part[(w * 4 + F.wave) * 64 + F.lane];
                ada[F.wave * (6 * D) + j] = s; }
            __syncthreads();
        }
    }
    __syncthreads();
    LAS unsigned* scr = (LAS unsigned*)(F.lds + F.wave * 8704);
    const int gw = F.bid * 8 + F.wave, NGW = F.G * 8;
    constexpr int NB_IN = ((FP8GATE ? SRC_ALR + GR : IN_COLS) + 127) / 128;
    constexpr int I_IN = ALR8 ? 0 : 32 * NB_IN, I_PA = FP8PA ? 0 : 16 * 16, I_PG = FP8PG ? 0 : 32 * 16, I_WO = FP8WO ? 0 : 32 * 16;
    constexpr int NITEMS = I_IN + I_PA + I_PG + I_WO;
    for (int it = gw; it < NITEMS; it += NGW) {
        int r = it;
        if (r < I_IN) { if (FP8GATE && 128 * (r / 32) >= C8_LO && 128 * (r / 32 + 1) <= SRC_ALR) continue;
            transpose_item2(a.w_in, D, IN_COLS, (bf16*)(ws + WS_WINT), scr, r % 32, r / 32, F.lane, RmWin()); continue; } r -= I_IN;
        if (r < I_PA) { transpose_item2(a.w_br_att, 1024, D, (bf16*)(ws + WS_PAT), scr, r % 16, r / 16, F.lane, RmIdent()); continue; } r -= I_PA;
        if (r < I_PG) { transpose_item2(a.w_br_gla, D, D, (bf16*)(ws + WS_PGT), scr, r % 32, r / 32, F.lane, RmIdent()); continue; } r -= I_PG;
        transpose_item2(a.w_out, D, D, (bf16*)(ws + WS_WOT), scr, r % 32, r / 32, F.lane, RmIdent());
    }
#if FP8PA
    { constexpr int NIT = 8 * (D / 64);
      for (int it = (gw + NGW - 512) % NGW; it < NIT; it += NGW) { const int kbp = it % 8, nb = it / 8;
#pragma unroll 1
          for (int sub = 0; sub < 2; ++sub) { SubT t; const int kb = 2 * kbp + sub; t.N = D; t.n0 = 64 * nb; t.gu = 0;
              t.src = a.w_br_att + (size_t)(64 * kb) * D + t.n0; t.dst = (bf16*)(ws + WS_PA8 + 64 * kb);
              f32x4 v[16]; subt_load(t, F.lane, v); subt_store8(t, F.lane, v, scr, 1024); } } }
#endif
#if FP8PG
    { constexpr int NIT = 16 * (D / 64);
      for (int it = (gw + NGW - 1024) % NGW; it < NIT; it += NGW) { const int kbp = it % 16, nb = it / 16;
#pragma unroll 1
          for (int sub = 0; sub < 2; ++sub) { SubT t; const int kb = 2 * kbp + sub; t.N = D; t.n0 = 64 * nb; t.gu = 0;
              t.src = a.w_br_gla + (size_t)(64 * kb) * D + t.n0; t.dst = (bf16*)(ws + WS_PG8 + 64 * kb);
              f32x4 v[16]; subt_load(t, F.lane, v); subt_store8(t, F.lane, v, scr); } } }
#endif
#if FP8WO
    { constexpr int NIT = 16 * (D / 64);
      for (int it = NGW - 1 - gw; it < NIT; it += NGW) { const int kbp = it % 16, nb = it / 16;
#pragma unroll 1
          for (int sub = 0; sub < 2; ++sub) { SubT t; const int kb = 2 * kbp + sub; t.N = D; t.n0 = 64 * nb; t.gu = 0;
              t.src = a.w_out + (size_t)(64 * kb) * D + t.n0; t.dst = (bf16*)(ws + WS_WO8 + 64 * kb);
              f32x4 v[16]; subt_load(t, F.lane, v); subt_store8(t, F.lane, v, scr); } } }
#endif
#if FP8GATE
#if ALR8
    { GAS unsigned* z = (GAS unsigned*)(ws + WS_WG8 + (size_t)N8 * D); const int nd = 256 * D / 4;
      for (int i = F.bid * 512 + F.tid; i < nd; i += F.G * 512) { unsigned o = 0u;
          if (i < GR * D / 4) { const int n = i / (D / 4), k = 4 * (i % (D / 4)); const float* wp = a.w_in + (size_t)k * IN_COLS + SRC_ALR + n;
              o = pk4_fp8(64.f * wp[0], 64.f * wp[IN_COLS], 64.f * wp[2 * IN_COLS], 64.f * wp[3 * IN_COLS]); }
          z[i] = o; } }
#else
    { GAS v4u* z = (GAS v4u*)((bf16*)(ws + WS_WINT) + (size_t)(PJ + GR) * D); const int n16 = (NPAD - PJ - GR) * D * 2 / 16;
      for (int i = F.bid * 512 + F.tid; i < n16; i += F.G * 512) z[i] = (v4u){0u, 0u, 0u, 0u}; }
#endif
    { constexpr int NIT = 16 * (N8 / 64);
      for (int it = gw; it < NIT; it += NGW) { const int kbp = it % 16, nb = it / 16;
#pragma unroll 1
          for (int sub = 0; sub < 2; ++sub) { SubT t; const int kb = 2 * kbp + sub; t.N = IN_COLS; t.n0 = 64 * nb; t.gu = 0;
              const int sc0 = C8_LO + t.n0 + (C8_LO + t.n0 >= SRC_ALR ? GR : 0);
              t.src = a.w_in + (size_t)(64 * kb) * IN_COLS + sc0; t.dst = (bf16*)(ws + WS_WG8 + 64 * kb);
              f32x4 v[16]; subt_load(t, F.lane, v); subt_store8(t, F.lane, v, scr); } } }
#else
    { GAS v4u* z = (GAS v4u*)((bf16*)(ws + WS_WINT) + (size_t)(PJ + GR) * D); const int n16 = (NPAD - PJ - GR) * D * 2 / 16;
      for (int i = F.bid * 512 + F.tid; i < n16; i += F.G * 512) z[i] = (v4u){0u, 0u, 0u, 0u}; }
#endif
    __syncthreads();
}
__device__ __forceinline__ void phase_convert_moe(const Frame& F, const Args& a, int ci, int nconv) {
    unsigned char* ws = a.ws;
    LAS unsigned* scr = (LAS unsigned*)(F.lds + F.wave * 8704);
    const int gw = ci * 8 + F.wave, NGW = nconv * 8;
    constexpr int NITEMS = NE * (32 * 64 + 32 * 32);
    const int nsub = (gw < NITEMS / 2) ? 2 * ((NITEMS / 2 - gw + NGW - 1) / NGW) : 0;
#define CQ(j) (((gw + ((j) >> 1) * NGW) << 1) | ((j) & 1))
#if FP8MOE
#define subt_store subt_store8
#endif
    f32x4 ra[16], rb[16], rc[16]; SubT ta, tb, tcx;
    if (nsub > 0) { ta = moe_subtile(a, ws, CQ(0)); subt_load(ta, F.lane, ra); tb = ta; tcx = ta; }
    if (nsub > 1) { tb = moe_subtile(a, ws, CQ(1)); subt_load(tb, F.lane, rb); }
    for (int j = 0; j < nsub; j += 3) {
        if (j + 2 < nsub) { tcx = moe_subtile(a, ws, CQ(j + 2)); subt_load(tcx, F.lane, rc); }
        subt_store(ta, F.lane, ra, scr);
        if (j + 1 < nsub) { if (j + 3 < nsub) { ta = moe_subtile(a, ws, CQ(j + 3)); subt_load(ta, F.lane, ra); }
            subt_store(tb, F.lane, rb, scr); }
        if (j + 2 < nsub) { if (j + 4 < nsub) { tb = moe_subtile(a, ws, CQ(j + 4)); subt_load(tb, F.lane, rb); }
            subt_store(tcx, F.lane, rc, scr); }
    }
#undef CQ
#if FP8MOE
#undef subt_store
#endif
    __syncthreads();
}

#if FP8MOE
__device__ __forceinline__ void conv_issue_stage(const Args& a, unsigned char* ws, int it, int s, LAS unsigned char* slot, int lane) {
    const SubT t = moe_subtile(a, ws, it);
    const float* src = t.src + (size_t)(16 * s + 4 * (lane >> 4)) * t.N + (lane & 15) * 4;
#pragma unroll
    for (int q = 0; q < 4; ++q) __builtin_amdgcn_global_load_lds((const unsigned*)(src + (size_t)q * t.N), (LAS unsigned*)(slot + q * 1024), 16, 0, 2);
}
__device__ __forceinline__ void phase_convert_moe_dma(const Frame& F, const Args& a, int ci, int nconv, int pair0, int npairs) {
    unsigned char* ws = a.ws;
    if (F.wave < 4) {
        const int cw = ci * 4 + F.wave, NCW = nconv * 4;
        const int nitem = (cw < npairs) ? 2 * ((npairs - cw + NCW - 1) / NCW) : 0;
#define CQ(j) (((pair0 + cw + ((j) >> 1) * NCW) << 1) | ((j) & 1))
        LAS unsigned char* ring = F.lds + F.wave * 32768;
        LAS unsigned* scr = (LAS unsigned*)(F.lds + 131072 + F.wave * 4352);
        const int g = F.lane >> 4, n4 = (F.lane & 15) * 4;
        const int nst = nitem * 4;
        for (int st = 0; st < 7 && st < nst; ++st) conv_issue_stage(a, ws, CQ(st >> 2), st & 3, ring + (st & 7) * 4096, F.lane);
        SubT tcur = moe_subtile(a, ws, CQ(0));
        for (int st = 0; st < nst; ++st) {
            const int sidx = st & 3;
            if (st + 7 < nst) { conv_issue_stage(a, ws, CQ((st + 7) >> 2), (st + 7) & 3, ring + ((st + 7) & 7) * 4096, F.lane); asm volatile("s_waitcnt vmcnt(28)" ::: "memory"); }
            else asm volatile("s_waitcnt vmcnt(0)" ::: "memory");
            if (sidx == 0) tcur = moe_subtile(a, ws, CQ(st >> 2));
            const LAS unsigned char* slot = ring + (st & 7) * 4096 + F.lane * 16;
            const f32x4 v0 = *(const LAS f32x4*)slot, v1 = *(const LAS f32x4*)(slot + 1024), v2 = *(const LAS f32x4*)(slot + 2048), v3 = *(const LAS f32x4*)(slot + 3072);
#pragma unroll
            for (int c = 0; c < 4; ++c) scr[(n4 + c) * 17 + 4 * sidx + g] = pk4_fp8(v0[c] * 64.f, v1[c] * 64.f, v2[c] * 64.f, v3[c] * 64.f);
            if (sidx == 3) {
                LDS_WAIT(); asm volatile("" ::: "memory");
#pragma unroll
                for (int j = 0; j < 4; ++j) { const int n = (F.lane >> 2) + 16 * j, q = F.lane & 3, ng = tcur.n0 + n; const LAS unsigned* sp = scr + n * 17 + 4 * q;
                    const v4u o = (v4u){sp[0], sp[1], sp[2], sp[3]};
                    const int row = tcur.gu ? ((ng >> 8) * 256 + (ng & 1) * 128 + ((ng >> 1) & 127)) : ng;
                    *(GAS v4u*)((unsigned char*)tcur.dst + (size_t)row * D + 16 * q) = o; }
                LDS_WAIT(); asm volatile("" ::: "memory");
            }
        }
#undef CQ
    }
    __syncthreads();
}
#endif

__device__ __forceinline__ void load_row(const float* p, int lane, f32x4 (&v)[8]) {
    const GAS f32x4* r = (const GAS f32x4*)p + lane;
#pragma unroll
    for (int j = 0; j < 8; ++j) v[j] = r[64 * j];
}
__device__ __forceinline__ void row_stats(const f32x4 (&v)[8], float& mean, float& rstd) {
    float s = 0.f;
#pragma unroll
    for (int j = 0; j < 8; ++j) s += (v[j].x + v[j].y) + (v[j].z + v[j].w);
    mean = wave_sum(s) * (1.f / D); float s2 = 0.f;
#pragma unroll
    for (int j = 0; j < 8; ++j) { const f32x4 d = v[j] - mean; s2 += (d.x * d.x + d.y * d.y) + (d.z * d.z + d.w * d.w); }
    rstd = 1.f / sqrtf(wave_sum(s2) * (1.f / D) + LN_EPS);
}
__device__ __forceinline__ void phase_lnmod1(const Frame& F, const Args& a) {
    const float* ada = (const float*)(a.ws + WS_ADA); bf16* H = (bf16*)(a.ws + WS_H);
    const int gw = F.bid * 8 + F.wave, NGW = F.G * 8;
    for (int m = gw; m < M; m += NGW) {
        f32x4 v[8]; load_row(a.x + (size_t)m * D, F.lane, v);
        float mean, rstd; row_stats(v, mean, rstd);
        const int b = m / T; const float* sh = ada + b * 6 * D; const float* sc = sh + D;
        GAS v2u* o = (GAS v2u*)(H + (size_t)m * D) + F.lane;
#pragma unroll
        for (int j = 0; j < 8; ++j) { const int c0 = 4 * (F.lane + 64 * j); const f32x4 s = *(const f32x4*)(sc + c0), h = *(const f32x4*)(sh + c0);
            const f32x4 y = (v[j] - mean) * rstd * (s + 1.f) + h; if (!ALR8) { v2u w; w.x = pk2(y.x, y.y); w.y = pk2(y.z, y.w); o[64 * j] = w; }
            if (FP8GATE) ((GAS unsigned*)(a.ws + WS_H8A + (size_t)m * D) + F.lane)[64 * j] = pk4_fp8(y.x, y.y, y.z, y.w); }
    }
}

struct EpiProj {
    bf16* proj; float* alr; bf16* vat; bf16* vgt; bf16* qaf; bf16* kaf; bf16* vaf;
    __device__ __forceinline__ void operator()(const STile&, int row, int col, float v, float) const {
        if (col < PJ) { float y = v; if (col >= C_RG) y = (col < C_GA) ? siluf_(v) : sigmoidf_(v); proj[(size_t)row * PJ + col] = (bf16)f2bf(y);
            const int b = row / T, ts = row % T, qt = ts >> 5, nt = ts & 31;
            if (col < C_KA) { const int hq = col >> 6, d = col & 63; qaf[((((size_t)(b * AH + hq) * (T / 32) + qt) * 4 + (d >> 4)) * 64 + ((d >> 3) & 1) * 32 + nt) * 8 + (d & 7)] = (bf16)f2bf(v); }
            else if (col < C_VA) { const int c = col - C_KA, kh = c >> 6, d = c & 63; kaf[((((size_t)(b * AKV + kh) * (T / 32) + qt) * 4 + (d >> 4)) * 64 + ((d >> 3) & 1) * 32 + nt) * 8 + (d & 7)] = (bf16)f2bf(v); }
            else if (col < C_QG) { const int c = col - C_VA, kh = c >> 6, d = c & 63, s2 = nt >> 4, r16 = nt & 15, jj = 4 * (r16 >> 3) + (r16 & 3), hh = (r16 >> 2) & 1;
                vaf[(((((size_t)(b * AKV + kh) * (T / 32) + qt) * 2 + (d >> 5)) * 2 + s2) * 64 + hh * 32 + (d & 31)) * 8 + jj] = (bf16)f2bf(v);
                vat[((size_t)(b * AKV + kh) * AD + d) * T + ts] = (bf16)f2bf(v); }
            if (col >= C_VG && col < C_RG) { const int c = col - C_VG, t = ts & 63, dv = c % GHV; const int uu = (b * GH + c / GHV) * GNC + (ts >> 6);
                vgt[((((size_t)uu * 16 + (dv >> 5)) * 4 + (t >> 4)) * 64 + ((t >> 3) & 1) * 32 + (dv & 31)) * 8 + (t & 7)] = (bf16)f2bf(v); } }
        else if (col < PJ + GR) alr[(size_t)row * GR + (col - PJ)] = v;
    }
};

__device__ __forceinline__ void phase_attn_simple(const Frame& F, const Args& a) {
    const bf16* proj = (const bf16*)(a.ws + WS_PROJ); bf16* yatt = (bf16*)(a.ws + WS_YATT);
    LAS float* Ks = (LAS float*)F.lds; LAS float* Vs = (LAS float*)(F.lds + 69632);
    for (int u = F.bid; u < NB * (T / 128) * AH; u += F.G) {
        const int b = u / ((T / 128) * AH), rem = u % ((T / 128) * AH), n = rem / AH, hq = rem % AH, kh = hq / 8;
        const int t0 = n * 128;
        __syncthreads();
        { const int j = F.tid >> 1, hf = F.tid & 1; const int s = t0 - 128 + j;
          LAS float* kd = Ks + j * 68 + 32 * hf; LAS float* vd = Vs + j * 68 + 32 * hf;
          if (s >= 0) { const bf16* kp = proj + (size_t)(b * T + s) * PJ + C_KA + kh * 64 + 32 * hf; const bf16* vp = proj + (size_t)(b * T + s) * PJ + C_VA + kh * 64 + 32 * hf;
#pragma unroll
              for (int q = 0; q < 4; ++q) { const v4u kw = *(const GAS v4u*)(kp + 8 * q), vw = *(const GAS v4u*)(vp + 8 * q);
                  *(LAS f32x4*)(kd + 8 * q) = (f32x4){bflo(kw.x), bfhi(kw.x), bflo(kw.y), bfhi(kw.y)}; *(LAS f32x4*)(kd + 8 * q + 4) = (f32x4){bflo(kw.z), bfhi(kw.z), bflo(kw.w), bfhi(kw.w)};
                  *(LAS f32x4*)(vd + 8 * q) = (f32x4){bflo(vw.x), bfhi(vw.x), bflo(vw.y), bfhi(vw.y)}; *(LAS f32x4*)(vd + 8 * q + 4) = (f32x4){bflo(vw.z), bfhi(vw.z), bflo(vw.w), bfhi(vw.w)}; }
          } else {
#pragma unroll
              for (int q = 0; q < 8; ++q) { *(LAS f32x4*)(kd + 4 * q) = (f32x4){0.f, 0.f, 0.f, 0.f}; *(LAS f32x4*)(vd + 4 * q) = (f32x4){0.f, 0.f, 0.f, 0.f}; } }
        }
        __syncthreads();
        const int qi = F.tid >> 2, part = F.tid & 3;
        float q[64];
        { const bf16* qp = proj + (size_t)(b * T + t0 + qi) * PJ + C_QA + hq * 64;
#pragma unroll
          for (int i = 0; i < 8; ++i) { const v4u w = *(const GAS v4u*)(qp + 8 * i);
              q[8 * i + 0] = bflo(w.x) * 0.125f; q[8 * i + 1] = bfhi(w.x) * 0.125f; q[8 * i + 2] = bflo(w.y) * 0.125f; q[8 * i + 3] = bfhi(w.y) * 0.125f;
              q[8 * i + 4] = bflo(w.z) * 0.125f; q[8 * i + 5] = bfhi(w.z) * 0.125f; q[8 * i + 6] = bflo(w.w) * 0.125f; q[8 * i + 7] = bfhi(w.w) * 0.125f; } }
        const float slope = exp2f(-0.5f * (float)(hq + 1)), sink = a.sinks[hq];
        float mloc = -INFINITY;
#pragma unroll 1
        for (int jj = 0; jj < 32; ++jj) {
            const int w = 32 * part + jj, row = qi + 1 + w; const bool ok = (n > 0) || (row >= 128);
            const LAS float* kr = Ks + row * 68; float d0 = 0.f, d1 = 0.f;
#pragma unroll
            for (int i = 0; i < 16; ++i) { const f32x4 kv = *(const LAS f32x4*)(kr + 4 * i); d0 += q[4 * i] * kv.x + q[4 * i + 1] * kv.y; d1 += q[4 * i + 2] * kv.z + q[4 * i + 3] * kv.w; }
            const float s = ok ? (d0 + d1) - slope * (float)(127 - w) : -INFINITY; mloc = fmaxf(mloc, s);
        }
        mloc = fmaxf(mloc, __shfl_xor(mloc, 1)); mloc = fmaxf(mloc, __shfl_xor(mloc, 2));
        const float mx = fmaxf(mloc, sink);
        float o[64]; float l = 0.f;
#pragma unroll
        for (int i = 0; i < 64; ++i) o[i] = 0.f;
#pragma unroll 1
        for (int jj = 0; jj < 32; ++jj) {
            const int w = 32 * part + jj, row = qi + 1 + w; const bool ok = (n > 0) || (row >= 128);
            const LAS float* kr = Ks + row * 68; float d0 = 0.f, d1 = 0.f;
#pragma unroll
            for (int i = 0; i < 16; ++i) { const f32x4 kv = *(const LAS f32x4*)(kr + 4 * i); d0 += q[4 * i] * kv.x + q[4 * i + 1] * kv.y; d1 += q[4 * i + 2] * kv.z + q[4 * i + 3] * kv.w; }
            const float s = ok ? (d0 + d1) - slope * (float)(127 - w) : -INFINITY;
            const float p = __expf(s - mx); l += p;
            const LAS float* vr = Vs + row * 68;
#pragma unroll
            for (int i = 0; i < 16; ++i) { const f32x4 vv = *(const LAS f32x4*)(vr + 4 * i); o[4 * i] += p * vv.x; o[4 * i + 1] += p * vv.y; o[4 * i + 2] += p * vv.z; o[4 * i + 3] += p * vv.w; }
        }
        l += __shfl_xor(l, 1); l += __shfl_xor(l, 2);
#pragma unroll
        for (int i = 0; i < 64; ++i) { o[i] += __shfl_xor(o[i], 1); o[i] += __shfl_xor(o[i], 2); }
        const float inv = 1.f / (l + __expf(sink - mx));
        bf16* op = yatt + (size_t)(b * T + t0 + qi) * (AH * AD) + hq * 64;
#pragma unroll
        for (int pp = 0; pp < 4; ++pp) if (part == pp) {
            v4u w0, w1;
            w0.x = pk2(o[16 * pp + 0] * inv, o[16 * pp + 1] * inv); w0.y = pk2(o[16 * pp + 2] * inv, o[16 * pp + 3] * inv); w0.z = pk2(o[16 * pp + 4] * inv, o[16 * pp + 5] * inv); w0.w = pk2(o[16 * pp + 6] * inv, o[16 * pp + 7] * inv);
            w1.x = pk2(o[16 * pp + 8] * inv, o[16 * pp + 9] * inv); w1.y = pk2(o[16 * pp + 10] * inv, o[16 * pp + 11] * inv); w1.z = pk2(o[16 * pp + 12] * inv, o[16 * pp + 13] * inv); w1.w = pk2(o[16 * pp + 14] * inv, o[16 * pp + 15] * inv);
            *(GAS v4u*)(op + 16 * pp) = w0; *(GAS v4u*)(op + 16 * pp + 8) = w1; }
    }
    __syncthreads();
}

typedef float f32x16 __attribute__((ext_vector_type(16)));
__device__ __forceinline__ void phase_attn_mfma(const Frame& F, const Args& a) {
    const bf16* qaf = (const bf16*)(a.ws + WS_QAF); const bf16* kaf = (const bf16*)(a.ws + WS_KAF); const bf16* vaf = (const bf16*)(a.ws + WS_VAF); bf16* yatt = (bf16*)(a.ws + WS_YATT);
    const int n = F.lane & 31, h = F.lane >> 5;
    for (int u = F.bid; u < (M / 32) * AKV; u += F.G) {
        const int kh = u & 1, qt = u >> 1, b = qt / (T / 32), qtl = qt % (T / 32), tq0 = qtl * 32, hq = kh * 8 + F.wave;
        const float slope = exp2f(-0.5f * (float)(hq + 1)), sink = a.sinks[hq];
        bf16x8 bq[4];
        { const bf16* qp = qaf + ((((size_t)(b * AH + hq) * (T / 32) + qtl) * 4) * 64 + F.lane) * 8;
#pragma unroll
          for (int s = 0; s < 4; ++s) bq[s] = *(const GAS bf16x8*)(qp + 512 * s); }
        f32x16 st[5];
#pragma unroll
        for (int kt = 0; kt < 5; ++kt) {
            const int ktl = qtl - 4 + kt;
#pragma unroll
            for (int r = 0; r < 16; ++r) st[kt][r] = 0.f;
            if (ktl >= 0) {
                const bf16* kp = kaf + ((((size_t)(b * AKV + kh) * (T / 32) + ktl) * 4) * 64 + F.lane) * 8;
                bf16x8 ak[4];
#pragma unroll
                for (int s = 0; s < 4; ++s) ak[s] = *(const GAS bf16x8*)(kp + 512 * s);
#pragma unroll
                for (int s = 0; s < 4; ++s) st[kt] = __builtin_amdgcn_mfma_f32_32x32x16_bf16(ak[s], bq[s], st[kt], 0, 0, 0);
            }
        }
        bf16x8 av[5][2][2];
#pragma unroll
        for (int kt = 0; kt < 5; ++kt) { const int ktl = qtl - 4 + kt; const int ktc = ktl >= 0 ? ktl : 0;
            const bf16* vp = vaf + ((((size_t)(b * AKV + kh) * (T / 32) + ktc) * 4) * 64 + F.lane) * 8;
#pragma unroll
            for (int dt = 0; dt < 2; ++dt)
#pragma unroll
                for (int s2 = 0; s2 < 2; ++s2) av[kt][dt][s2] = *(const GAS bf16x8*)(vp + 1024 * dt + 512 * s2); }
        const int t = tq0 + n; const int lb = n - 4 * h; const float fb = -slope * (float)lb; float mloc = -INFINITY;
#pragma unroll
        for (int kt = 0; kt < 5; ++kt) { const bool live = (qtl - 4 + kt) >= 0;
#pragma unroll
            for (int r = 0; r < 16; ++r) { const int C = 128 - 32 * kt - ((r & 3) + 8 * (r >> 2));
                float v = fmaf(-slope, (float)C, fmaf(st[kt][r], 0.125f, fb));
                if (kt == 0) v = (lb + C < WIN) ? v : -INFINITY;
                if (kt == 4) v = (lb + C >= 0) ? v : -INFINITY;
                if (!live) v = -INFINITY;
                st[kt][r] = v; mloc = fmaxf(mloc, v); } }
        mloc = fmaxf(mloc, __shfl_xor(mloc, 32));
        const float mx = fmaxf(mloc, sink); float l = 0.f;
        const float mxl = mx * 1.4426950408889634f;
#pragma unroll
        for (int kt = 0; kt < 5; ++kt)
#pragma unroll
            for (int r = 0; r < 16; ++r) { const float p = __builtin_amdgcn_exp2f(fmaf(st[kt][r], 1.4426950408889634f, -mxl)); st[kt][r] = p; l += p; }
        l += __shfl_xor(l, 32);
        const float inv = __builtin_amdgcn_rcpf(l + __expf(sink - mx));
        f32x16 o0, o1;
#pragma unroll
        for (int r = 0; r < 16; ++r) { o0[r] = 0.f; o1[r] = 0.f; }
#pragma unroll
        for (int kt = 0; kt < 5; ++kt) {
            if ((qtl - 4 + kt) >= 0) {
#pragma unroll
                for (int s2 = 0; s2 < 2; ++s2) {
                    v4u pw; pw.x = pk2(st[kt][8 * s2 + 0], st[kt][8 * s2 + 1]); pw.y = pk2(st[kt][8 * s2 + 2], st[kt][8 * s2 + 3]); pw.z = pk2(st[kt][8 * s2 + 4], st[kt][8 * s2 + 5]); pw.w = pk2(st[kt][8 * s2 + 6], st[kt][8 * s2 + 7]);
                    const bf16x8 pb = __builtin_bit_cast(bf16x8, pw);
                    o0 = __builtin_amdgcn_mfma_f32_32x32x16_bf16(av[kt][0][s2], pb, o0, 0, 0, 0);
                    o1 = __builtin_amdgcn_mfma_f32_32x32x16_bf16(av[kt][1][s2], pb, o1, 0, 0, 0);
                }
            }
        }
        bf16* op = yatt + (size_t)(b * T + t) * (AH * AD) + hq * 64 + 4 * h;
#pragma unroll
        for (int g = 0; g < 4; ++g) {
#if FP8PA
            GAS unsigned char* o8 = (GAS unsigned char*)yatt + (size_t)(b * T + t) * (AH * AD) + hq * 64 + 4 * h + 8 * g; const float i16 = 16.f * inv;
            *(GAS unsigned*)o8 = pk4_fp8(o0[4 * g] * i16, o0[4 * g + 1] * i16, o0[4 * g + 2] * i16, o0[4 * g + 3] * i16);
            *(GAS unsigned*)(o8 + 32) = pk4_fp8(o1[4 * g] * i16, o1[4 * g + 1] * i16, o1[4 * g + 2] * i16, o1[4 * g + 3] * i16); }
#else
            v2u w0, w1; w0.x = pk2(o0[4 * g] * inv, o0[4 * g + 1] * inv); w0.y = pk2(o0[4 * g + 2] * inv, o0[4 * g + 3] * inv);
            w1.x = pk2(o1[4 * g] * inv, o1[4 * g + 1] * inv); w1.y = pk2(o1[4 * g + 2] * inv, o1[4 * g + 3] * inv);
            *(GAS v2u*)(op + 8 * g) = w0; *(GAS v2u*)(op + 32 + 8 * g) = w1; }
#endif
    }
}

__device__ __forceinline__ float logsig16(float z) { return (fminf(z, 0.f) - __logf(1.f + __expf(-fabsf(z)))) * (1.f / 16.f); }
__device__ __forceinline__ void phase_gla_prep_mfma(const Frame& F, const Args& a) {
    const bf16* proj = (const bf16*)(a.ws + WS_PROJ); const float* alr = (const float*)(a.ws + WS_ALR);
    bf16* QEF = (bf16*)(a.ws + WS_QEF); bf16* KEF = (bf16*)(a.ws + WS_KEF); bf16* AMF = (bf16*)(a.ws + WS_AMF); float* DL = (float*)(a.ws + WS_DLAST);
    LAS float* Al = (LAS float*)F.lds;
    LAS float* Tot = (LAS float*)(F.lds + 4096);
    LAS bf16* Qs = (LAS bf16*)(F.lds + 8192);
    LAS bf16* Ks = (LAS bf16*)(F.lds + 8192 + 33792);
    LAS bf16* KT = (LAS bf16*)(F.lds + 8192 + 2 * 33792);
    for (int u = F.bid; u < NB * GH * GNC; u += F.G) {
        const int bh = u / GNC, n = u % GNC, b = bh / GH, hd = bh % GH; const int m0 = b * T + n * GC;
        __syncthreads();
        for (int i = F.tid; i < GC * GR; i += 512) Al[i] = alr[(size_t)m0 * GR + i];
        __syncthreads();
        const int ch = F.tid & 255, th = F.tid >> 8, col = hd * GHK + ch;
        float wu[GR];
#pragma unroll
        for (int r = 0; r < GR; ++r) wu[r] = a.w_gla_up[r * GDK + col];
        const float bg = a.b_gla_gate[col];
        unsigned short qr[32], kr[32];
        { const bf16* qp = proj + (size_t)(m0 + th * 32) * PJ + C_QG + col;
#pragma unroll
          for (int tt = 0; tt < 32; ++tt) { qr[tt] = qp[(size_t)tt * PJ]; kr[tt] = qp[(size_t)tt * PJ + (C_KG - C_QG)]; } }
        float la[32]; float run = 0.f;
#pragma unroll
        for (int tt = 0; tt < 32; ++tt) { const int t = th * 32 + tt; float z = bg;
#pragma unroll
            for (int r = 0; r < GR; r += 4) { const f32x4 av = *(const LAS f32x4*)(Al + t * GR + r); z += av.x * wu[r] + av.y * wu[r + 1] + av.z * wu[r + 2] + av.w * wu[r + 3]; }
            la[tt] = logsig16(z); run += la[tt]; }
        Tot[th * 256 + ch] = run;
        __syncthreads();
        const float tot0 = Tot[ch], blast = tot0 + Tot[256 + ch];
        float cum = th ? tot0 : 0.f;
#pragma unroll
        for (int tt = 0; tt < 32; ++tt) { const int t = th * 32 + tt;
            cum += la[tt];
            const float qv = bf2f(qr[tt]), kv = bf2f(kr[tt]);
            const float e1 = __expf(cum);
            Qs[t * 264 + ch] = (bf16)f2bf(qv * (1.f / 16.f) * e1); Ks[t * 264 + ch] = (bf16)f2bf(kv * __expf(-cum)); KT[ch * 66 + t] = (bf16)f2bf(kv * __expf(blast - cum)); }
        if (th == 1) DL[(size_t)u * GHK + ch] = __expf(blast);
        __syncthreads();
        { const int ti = F.wave >> 1, fr = F.lane & 15, kg = F.lane >> 4;
#pragma unroll
          for (int tjj = 0; tjj < 2; ++tjj) { const int tj = 2 * (F.wave & 1) + tjj; f32x4 acc = (f32x4){0.f, 0.f, 0.f, 0.f};
#pragma unroll
              for (int s = 0; s < 8; ++s) { const bf16x8 af = *(const LAS bf16x8*)(Qs + (16 * ti + fr) * 264 + 32 * s + 8 * kg), bf_ = *(const LAS bf16x8*)(Ks + (16 * tj + fr) * 264 + 32 * s + 8 * kg);
                  acc = __builtin_amdgcn_mfma_f32_16x16x32_bf16(af, bf_, acc, 0, 0, 0); }
#pragma unroll
              for (int r = 0; r < 4; ++r) { const int i = 16 * ti + 4 * kg + r, j = 16 * tj + fr;
                  AMF[((((size_t)u * 2 + (i >> 5)) * 4 + (j >> 4)) * 64 + ((j >> 3) & 1) * 32 + (i & 31)) * 8 + (j & 7)] = (bf16)f2bf(j <= i ? acc[r] : 0.f); } } }
#pragma unroll
        for (int k = 0; k < 4; ++k) { const int pidx = F.tid + 512 * k, ln = pidx & 63, s = (pidx >> 6) & 1, tt = (pidx >> 7) & 1, w = pidx >> 8, n_ = ln & 31, h = ln >> 5;
            const LAS v2u* src = (const LAS v2u*)(Qs + (32 * tt + n_) * 264 + 32 * w + 16 * s + 4 * h); const v2u lo = src[0], hi = src[2];
            *(GAS v4u*)(QEF + ((size_t)u * 2048 + pidx) * 8) = (v4u){lo.x, lo.y, hi.x, hi.y}; }
#pragma unroll
        for (int k = 0; k < 4; ++k) { const int pidx = F.tid + 512 * k, ln = pidx & 63, s = (pidx >> 6) & 3, w = pidx >> 8, n_ = ln & 31, h = ln >> 5;
            const LAS unsigned* src = (const LAS unsigned*)(KT + (32 * w + n_) * 66 + 16 * s + 8 * h);
            *(GAS v4u*)(KEF + ((size_t)u * 2048 + pidx) * 8) = (v4u){src[0], src[1], src[2], src[3]}; }
    }
    __syncthreads();
}
__device__ __forceinline__ bf16x8 ld_perm8(const bf16* p) { const v2u lo = *(const GAS v2u*)p, hi = *(const GAS v2u*)(p + 8); return __builtin_bit_cast(bf16x8, (v4u){lo.x, lo.y, hi.x, hi.y}); }
struct ScanE { bf16x8 q00, q01, q10, q11, am, vj; };
struct ScanL { bf16x8 kf[4], vf[4]; f32x4 d4[4]; };
__device__ __forceinline__ void scan_load_e(ScanE& o, const bf16* QEF, const bf16* VGF, const bf16* AMF, int u, int sl, int w, int lane, int ttw, int js) {
    const bf16* qb = QEF + (((size_t)u * 8 + w) * 4 * 64 + lane) * 8;
    o.q00 = *(const GAS bf16x8*)qb; o.q01 = *(const GAS bf16x8*)(qb + 512); o.q10 = *(const GAS bf16x8*)(qb + 1024); o.q11 = *(const GAS bf16x8*)(qb + 1536);
    o.am = *(const GAS bf16x8*)(AMF + ((((size_t)u * 2 + ttw) * 4 + js) * 64 + lane) * 8);
    o.vj = *(const GAS bf16x8*)(VGF + ((((size_t)u * 16 + sl) * 4 + js) * 64 + lane) * 8);
}
__device__ __forceinline__ void scan_load_l(ScanL& o, const bf16* KEF, const bf16* VGF, const float* DL, int u, int sl, int w, int lane, int h) {
    const bf16* kb = KEF + (((size_t)u * 8 + w) * 4 * 64 + lane) * 8; const bf16* vb = VGF + (((size_t)u * 16 + sl) * 4 * 64 + lane) * 8;
#pragma unroll
    for (int s = 0; s < 4; ++s) { o.kf[s] = *(const GAS bf16x8*)(kb + 512 * s); o.vf[s] = *(const GAS bf16x8*)(vb + 512 * s); }
#pragma unroll
    for (int g = 0; g < 4; ++g) o.d4[g] = *(const GAS f32x4*)(DL + (size_t)u * GHK + 32 * w + 8 * g + 4 * h);
}
__device__ __forceinline__ void phase_gla_scan_mfma(const Frame& F, const Args& a) {
    const bf16* QE = (const bf16*)(a.ws + WS_QEF); const bf16* KENDT = (const bf16*)(a.ws + WS_KEF); const bf16* VGT = (const bf16*)(a.ws + WS_VGT);
    const bf16* AM = (const bf16*)(a.ws + WS_AMF); const float* DL = (const float*)(a.ws + WS_DLAST); bf16* OG = (bf16*)(a.ws + WS_OG);
    LAS float* P = (LAS float*)F.lds;
    const int n_ = F.lane & 31, h = F.lane >> 5, w = F.wave, ttw = w >> 2, js = w & 3;
    const int vcu = (F.G % 8 == 0) ? (F.bid % 8) * (F.G / 8) + F.bid / 8 : F.bid;
    for (int item = vcu; item < NB * GH * 16; item += F.G) {
        const int bh = item >> 4, sl = item & 15, b = bh / GH, hd = bh % GH;
        f32x16 S;
#pragma unroll
        for (int r = 0; r < 16; ++r) S[r] = 0.f;
        __syncthreads();
        ScanE e0, e1; ScanL l0;
        scan_load_e(e0, QE, VGT, AM, bh * GNC, sl, w, F.lane, ttw, js); scan_load_l(l0, KENDT, VGT, DL, bh * GNC, sl, w, F.lane, h);
        scan_load_e(e1, QE, VGT, AM, bh * GNC + 1, sl, w, F.lane, ttw, js);
        for (int n = 0; n < GNC; ++n) {
            const int m0 = b * T + n * GC;
            const int n2 = (n + 2 < GNC) ? n + 2 : GNC - 1, n1 = (n + 1 < GNC) ? n + 1 : GNC - 1;
            ScanE e2; scan_load_e(e2, QE, VGT, AM, bh * GNC + n2, sl, w, F.lane, ttw, js);
            ScanL l1; scan_load_l(l1, KENDT, VGT, DL, bh * GNC + n1, sl, w, F.lane, h);
            v4u s0, s1; s0.x = pk2(S[0], S[1]); s0.y = pk2(S[2], S[3]); s0.z = pk2(S[4], S[5]); s0.w = pk2(S[6], S[7]); s1.x = pk2(S[8], S[9]); s1.y = pk2(S[10], S[11]); s1.z = pk2(S[12], S[13]); s1.w = pk2(S[14], S[15]);
            const bf16x8 sb0 = __builtin_bit_cast(bf16x8, s0), sb1 = __builtin_bit_cast(bf16x8, s1);
            f32x16 po0, po1;
#pragma unroll
            for (int r = 0; r < 16; ++r) { po0[r] = 0.f; po1[r] = 0.f; }
            po0 = __builtin_amdgcn_mfma_f32_32x32x16_bf16(e0.q00, sb0, po0, 0, 0, 0); po0 = __builtin_amdgcn_mfma_f32_32x32x16_bf16(e0.q01, sb1, po0, 0, 0, 0);
            po1 = __builtin_amdgcn_mfma_f32_32x32x16_bf16(e0.q10, sb0, po1, 0, 0, 0); po1 = __builtin_amdgcn_mfma_f32_32x32x16_bf16(e0.q11, sb1, po1, 0, 0, 0);
            if (ttw == 0) po0 = __builtin_amdgcn_mfma_f32_32x32x16_bf16(e0.am, e0.vj, po0, 0, 0, 0); else po1 = __builtin_amdgcn_mfma_f32_32x32x16_bf16(e0.am, e0.vj, po1, 0, 0, 0);
            LAS float* Pb = P + (n & 1) * 16384;
#pragma unroll
            for (int r = 0; r < 16; ++r) { Pb[((w * 2 + 0) * 16 + r) * 64 + F.lane] = po0[r]; Pb[((w * 2 + 1) * 16 + r) * 64 + F.lane] = po1[r]; }
#pragma unroll
            for (int r = 0; r < 16; ++r) S[r] *= l0.d4[r >> 2][r & 3];
#pragma unroll
            for (int s = 0; s < 4; ++s) S = __builtin_amdgcn_mfma_f32_32x32x16_bf16(l0.kf[s], l0.vf[s], S, 0, 0, 0);
            asm volatile("s_waitcnt lgkmcnt(0)" ::: "memory"); __builtin_amdgcn_s_barrier(); asm volatile("" ::: "memory");
            { const int tt = w >> 2, g = w & 3;
#pragma unroll
              for (int i = 0; i < 4; ++i) { const int r = 4 * g + i; float sum = 0.f;
#pragma unroll
                  for (int w2 = 0; w2 < 8; ++w2) sum += Pb[((w2 * 2 + tt) * 16 + r) * 64 + F.lane];
                  OG[(size_t)(m0 + 32 * tt + 8 * g + 4 * h + i) * GDV + hd * GHV + sl * 32 + n_] = (bf16)f2bf(sum); } }
            e0 = e1; e1 = e2; l0 = l1;
        }
    }
    __syncthreads();
}

__device__ __forceinline__ void phase_gla_prep_simple(const Frame& F, const Args& a) {
    const bf16* proj = (const bf16*)(a.ws + WS_PROJ); const float* alr = (const float*)(a.ws + WS_ALR);
    bf16* QE = (bf16*)(a.ws + WS_QE); bf16* KEND = (bf16*)(a.ws + WS_KEND); bf16* AM = (bf16*)(a.ws + WS_AMAT); float* DL = (float*)(a.ws + WS_DLAST);
    LAS float* Bq = (LAS float*)F.lds; LAS float* Ke = (LAS float*)(F.lds + 65536); LAS float* Al = (LAS float*)(F.lds + 131072); LAS float* Bl = (LAS float*)(F.lds + 131072 + 4096);
    for (int u = F.bid; u < NB * GH * GNC; u += F.G) {
        const int bh = u / GNC, n = u % GNC, b = bh / GH, h = bh % GH; const int m0 = b * T + n * GC;
        __syncthreads();
        for (int i = F.tid; i < GC * GR; i += 512) Al[i] = alr[(size_t)m0 * GR + i];
        __syncthreads();
        if (F.tid < GHK) {
            const int col = h * GHK + F.tid; float wu[GR];
#pragma unroll
            for (int r = 0; r < GR; ++r) wu[r] = a.w_gla_up[r * GDK + col];
            const float bg = a.b_gla_gate[col]; float run = 0.f;
            for (int t = 0; t < GC; ++t) { float z = bg;
#pragma unroll
                for (int r = 0; r < GR; ++r) z += Al[t * GR + r] * wu[r];
                const float ls = fminf(z, 0.f) - log1pf(__expf(-fabsf(z))); run += ls * (1.f / 16.f); Bq[t * GHK + F.tid] = run; }
            Bl[F.tid] = run; DL[(size_t)u * GHK + F.tid] = __expf(run);
        }
        __syncthreads();
#pragma unroll 4
        for (int k = 0; k < 32; ++k) { const int idx = F.tid + 512 * k, t = idx >> 8, i = idx & 255;
            const float bb = Bq[idx], bl = Bl[i];
            const float qv = bf2f(proj[(size_t)(m0 + t) * PJ + C_QG + h * GHK + i]), kv = bf2f(proj[(size_t)(m0 + t) * PJ + C_KG + h * GHK + i]);
            const float qe = qv * (1.f / 16.f) * __expf(bb), ke = kv * __expf(-bb), kend = kv * __expf(bl - bb);
            Bq[idx] = qe; Ke[idx] = ke; QE[(size_t)(m0 + t) * GDK + h * GHK + i] = (bf16)f2bf(qe); KEND[(size_t)(m0 + t) * GDK + h * GHK + i] = (bf16)f2bf(kend); }
        __syncthreads();
        { const int i = F.tid >> 3, j0 = (F.tid & 7) * 8; float acc[8];
#pragma unroll
          for (int e = 0; e < 8; ++e) acc[e] = 0.f;
          for (int d = 0; d < GHK; d += 4) { const f32x4 qv = *(const LAS f32x4*)(Bq + i * GHK + d);
#pragma unroll
              for (int e = 0; e < 8; ++e) { const f32x4 kv = *(const LAS f32x4*)(Ke + (j0 + e) * GHK + d); acc[e] += (qv.x * kv.x + qv.y * kv.y) + (qv.z * kv.z + qv.w * kv.w); } }
          v4u w; w.x = pk2(j0 + 0 <= i ? acc[0] : 0.f, j0 + 1 <= i ? acc[1] : 0.f); w.y = pk2(j0 + 2 <= i ? acc[2] : 0.f, j0 + 3 <= i ? acc[3] : 0.f);
          w.z = pk2(j0 + 4 <= i ? acc[4] : 0.f, j0 + 5 <= i ? acc[5] : 0.f); w.w = pk2(j0 + 6 <= i ? acc[6] : 0.f, j0 + 7 <= i ? acc[7] : 0.f);
          *(GAS v4u*)(AM + (size_t)u * GC * GC + i * GC + j0) = w; }
    }
    __syncthreads();
}

__device__ __forceinline__ void phase_gla_scan_simple(const Frame& F, const Args& a) {
    const bf16* proj = (const bf16*)(a.ws + WS_PROJ); const bf16* QE = (const bf16*)(a.ws + WS_QE); const bf16* KEND = (const bf16*)(a.ws + WS_KEND);
    const bf16* AM = (const bf16*)(a.ws + WS_AMAT); const float* DL = (const float*)(a.ws + WS_DLAST); bf16* OG = (bf16*)(a.ws + WS_OG);
    LAS float* S = (LAS float*)F.lds;
    LAS bf16* Qs = (LAS bf16*)(F.lds + 32768);
    LAS bf16* Kx = (LAS bf16*)(F.lds + 65536);
    LAS float* Vs = (LAS float*)(F.lds + 98304);
    LAS float* As = (LAS float*)(F.lds + 106496);
    LAS float* Ds = (LAS float*)(F.lds + 122880);
    for (int w = F.bid; w < NB * GH * 16; w += F.G) {
        const int bh = w >> 4, sl = w & 15, b = bh / GH, h = bh % GH;
        __syncthreads();
        for (int i = F.tid; i < GHK * 32; i += 512) S[i] = 0.f;
        for (int n = 0; n < GNC; ++n) {
            const int m0 = b * T + n * GC, u = bh * GNC + n;
            __syncthreads();
#pragma unroll
            for (int k = 0; k < 4; ++k) { const int idx = F.tid + 512 * k, t = idx >> 5, c = idx & 31;
                *(LAS v4u*)(Qs + t * GHK + 8 * c) = *(const GAS v4u*)(QE + (size_t)(m0 + t) * GDK + h * GHK + 8 * c);
                *(LAS v4u*)(Kx + t * GHK + 8 * c) = *(const GAS v4u*)(KEND + (size_t)(m0 + t) * GDK + h * GHK + 8 * c); }
#pragma unroll
            for (int k = 0; k < 4; ++k) { const int idx = F.tid + 512 * k, t = idx >> 5, c = idx & 31; Vs[idx] = bf2f(proj[(size_t)(m0 + t) * PJ + C_VG + h * GHV + sl * 32 + c]); }
#pragma unroll
            for (int k = 0; k < 8; ++k) { const int idx = F.tid + 512 * k; As[idx] = bf2f(AM[(size_t)u * GC * GC + idx]); }
            if (F.tid < GHK) Ds[F.tid] = DL[(size_t)u * GHK + F.tid];
            __syncthreads();
            { const int t = F.tid >> 3, dq = F.tid & 7; f32x4 o = (f32x4){0.f, 0.f, 0.f, 0.f};
              for (int j = 0; j < GC; ++j) { const float av = As[t * GC + j]; o += *(const LAS f32x4*)(Vs + j * 32 + 4 * dq) * av; }
              for (int dk = 0; dk < GHK; ++dk) { const float qv = bf2f(Qs[t * GHK + dk]); o += *(const LAS f32x4*)(S + dk * 32 + 4 * dq) * qv; }
              { v2u w_; w_.x = pk2(o.x, o.y); w_.y = pk2(o.z, o.w); *(GAS v2u*)(OG + (size_t)(m0 + t) * GDV + h * GHV + sl * 32 + 4 * dq) = w_; } }
            __syncthreads();
            { const int dk = F.tid >> 1, hv = F.tid & 1; const float dd = Ds[dk]; f32x4 s[4];
#pragma unroll
              for (int i = 0; i < 4; ++i) s[i] = *(const LAS f32x4*)(S + dk * 32 + 16 * hv + 4 * i) * dd;
              for (int j = 0; j < GC; ++j) { const float kv = bf2f(Kx[j * GHK + dk]);
#pragma unroll
                  for (int i = 0; i < 4; ++i) s[i] += *(const LAS f32x4*)(Vs + j * 32 + 16 * hv + 4 * i) * kv; }
#pragma unroll
              for (int i = 0; i < 4; ++i) *(LAS f32x4*)(S + dk * 32 + 16 * hv + 4 * i) = s[i]; }
        }
    }
    __syncthreads();
}

struct EpiT1 { const bf16* proj; bf16* t1;
    __device__ __forceinline__ void operator()(const STile&, int row, int col, float v, float) const { t1[(size_t)row * D + col] = (bf16)f2bf(v * bf2f(proj[(size_t)row * PJ + C_GA + col])); } };
__device__ __forceinline__ void phase_gla_finish(const Frame& F, const Args& a) {
    const bf16* OG = (const bf16*)(a.ws + WS_OG); const bf16* proj = (const bf16*)(a.ws + WS_PROJ); bf16* Y = (bf16*)(a.ws + WS_YGLA);
    const int gw = F.bid * 8 + F.wave, NGW = F.G * 8;
    for (int m = gw; m < M; m += NGW) {
        f32x4 v[8]; { const GAS v2u* op = (const GAS v2u*)(OG + (size_t)m * GDV) + F.lane;
#pragma unroll
            for (int j = 0; j < 8; ++j) { const v2u r = op[64 * j]; v[j] = (f32x4){bflo(r.x), bfhi(r.x), bflo(r.y), bfhi(r.y)}; } }
        float rs[4];
#pragma unroll
        for (int h = 0; h < 4; ++h) { float s = 0.f;
#pragma unroll
            for (int j = 2 * h; j < 2 * h + 2; ++j) s += (v[j].x * v[j].x + v[j].y * v[j].y) + (v[j].z * v[j].z + v[j].w * v[j].w);
            rs[h] = 1.f / sqrtf(wave_sum(s) * (1.f / GHV) + LN_EPS); }
        GAS v2u* o = (GAS v2u*)(Y + (size_t)m * GDV) + F.lane; const GAS v2u* rg = (const GAS v2u*)(proj + (size_t)m * PJ + C_RG) + F.lane;
#pragma unroll
        for (int j = 0; j < 8; ++j) { const int c0 = 4 * (F.lane + 64 * j); const f32x4 g = *(const f32x4*)(a.gla_gain + c0); const v2u r = rg[64 * j];
            const f32x4 y = v[j] * rs[j >> 1] * g * (f32x4){bflo(r.x), bfhi(r.x), bflo(r.y), bfhi(r.y)};
#if FP8PG
            ((GAS unsigned*)((unsigned char*)Y + (size_t)m * GDV) + F.lane)[64 * j] = pk4_fp8(8.f * y.x, 8.f * y.y, 8.f * y.z, 8.f * y.w); }
#else
            v2u w; w.x = pk2(y.x, y.y); w.y = pk2(y.z, y.w); o[64 * j] = w; }
#endif
    }
}
struct EpiMerged { const bf16* proj; const bf16* t1; bf16* mg;
    __device__ __forceinline__ void operator()(const STile&, int row, int col, float v, float) const { mg[(size_t)row * D + col] = (bf16)f2bf(bf2f(t1[(size_t)row * D + col]) + v * bf2f(proj[(size_t)row * PJ + C_GG + col])); } };
struct EpiU { const float* x; const float* ada; bf16* u;
    __device__ __forceinline__ void operator()(const STile&, int row, int col, float v, float) const { const int b = row / T; u[(size_t)row * D + col] = (bf16)f2bf(ada[b * 6 * D + 2 * D + col] * v); } };

__device__ __forceinline__ void phase_ln_router(const Frame& F, const Args& a) {
    const float* U = (const float*)(a.ws + WS_U); float* X1 = (float*)(a.ws + WS_X1); bf16* H = (bf16*)(a.ws + WS_H); const float* ada = (const float*)(a.ws + WS_ADA);
    int* TOPE = (int*)(a.ws + WS_TOPE); float* TOPW = (float*)(a.ws + WS_TOPW); int* HIST = (int*)(a.ws + WS_HIST);
    LAS float* hs = (LAS float*)(F.lds + F.wave * 8192);
    LAS int* cnt = (LAS int*)(F.lds + 65536);
    for (int vb = F.bid; vb < 256; vb += F.G) {
        __syncthreads();
        if (F.tid < NE) cnt[F.tid] = 0;
        __syncthreads();
        for (int rr = 0; rr < 8; ++rr) {
            const int m = vb * 64 + F.wave * 8 + rr, b = m / T;
            f32x4 v[8]; load_row(U + (size_t)m * D, F.lane, v);
            float mean, rstd; row_stats(v, mean, rstd);
            GAS f32x4* xo = (GAS f32x4*)(X1 + (size_t)m * D) + F.lane;
#pragma unroll
            for (int j = 0; j < 8; ++j) { const int c0 = 4 * (F.lane + 64 * j); v[j] = (v[j] - mean) * rstd * *(const f32x4*)(a.ln1_g + c0) + *(const f32x4*)(a.ln1_b + c0); xo[64 * j] = v[j]; }
            row_stats(v, mean, rstd);
            const float* sh = ada + b * 6 * D + 3 * D; const float* sc = sh + D;
            GAS v2u* ho = (GAS v2u*)(H + (size_t)m * D) + F.lane;
#pragma unroll
            for (int j = 0; j < 8; ++j) { const int c0 = 4 * (F.lane + 64 * j); const f32x4 y = (v[j] - mean) * rstd * (*(const f32x4*)(sc + c0) + 1.f) + *(const f32x4*)(sh + c0);
                v2u w; w.x = pk2(y.x, y.y); w.y = pk2(y.z, y.w); ho[64 * j] = w; *(LAS f32x4*)(hs + c0) = y; }
            LDS_WAIT(); asm volatile("" ::: "memory");
            const int e = F.lane & 31, kh = F.lane >> 5; float acc = 0.f;
            const float* wp = a.w_router + (size_t)(kh * 1024) * NE + e; const LAS float* hp = hs + kh * 1024;
#pragma unroll 16
            for (int k = 0; k < 1024; ++k) acc += hp[k] * wp[(size_t)k * NE];
            acc += __shfl_xor(acc, 32);
            float val = (F.lane < 32) ? acc + a.b_router[e] : -INFINITY;
            float sv[4]; int si[4];
#pragma unroll
            for (int r = 0; r < 4; ++r) { float mv = val; int mi = F.lane;
#pragma unroll
                for (int o = 1; o < 32; o <<= 1) { const float ov = __shfl_xor(mv, o); const int oi = __shfl_xor(mi, o); if (ov > mv || (ov == mv && oi < mi)) { mv = ov; mi = oi; } }
                mv = __shfl(mv, 0); mi = __shfl(mi, 0); sv[r] = mv; si[r] = mi; if (F.lane == mi) val = -INFINITY; }
            const float e1 = __expf(sv[1] - sv[0]), e2 = __expf(sv[2] - sv[0]), e3 = __expf(sv[3] - sv[0]), inv = 1.f / (1.f + e1 + e2 + e3);
            if (F.lane == 0) { *(int4*)(TOPE + (size_t)m * 4) = make_int4(si[0], si[1], si[2], si[3]); *(f32x4*)(TOPW + (size_t)m * 4) = (f32x4){inv, e1 * inv, e2 * inv, e3 * inv};
                atomicAdd((int*)&cnt[si[0]], 1); atomicAdd((int*)&cnt[si[1]], 1); atomicAdd((int*)&cnt[si[2]], 1); atomicAdd((int*)&cnt[si[3]], 1); }
            LDS_WAIT(); asm volatile("" ::: "memory");
        }
        __syncthreads();
        if (F.tid < NE) HIST[vb * NE + F.tid] = cnt[F.tid];
    }
    __syncthreads();
}
struct URow { f32x4 x[8]; v2u g[8]; };
__device__ __forceinline__ void urow_load(URow& r, const float* x, const bf16* mixg, int m, int lane) {
    load_row(x + (size_t)m * D, lane, r.x); const GAS v2u* gp = (const GAS v2u*)(mixg + (size_t)m * D) + lane;
#pragma unroll
    for (int j = 0; j < 8; ++j) r.g[j] = gp[64 * j];
}
__device__ __forceinline__ void lnr_stage_a(const Frame& F, const Args& a, int m, int r, const URow& ur, LAS float* hT, float* X1, bf16* H, const float* ada) {
    GAS unsigned* h8 = (GAS unsigned*)(a.ws + WS_H8 + (size_t)m * D) + F.lane;
    f32x4 v[8];
#pragma unroll
    for (int j = 0; j < 8; ++j) v[j] = ur.x[j] * DN_ALPHA + (f32x4){bflo(ur.g[j].x), bfhi(ur.g[j].x), bflo(ur.g[j].y), bfhi(ur.g[j].y)};
    const int b = m / T; float mean, rstd; row_stats(v, mean, rstd);
    GAS f32x4* xo = (GAS f32x4*)(X1 + (size_t)m * D) + F.lane;
#pragma unroll
    for (int j = 0; j < 8; ++j) { const int c0 = 4 * (F.lane + 64 * j); v[j] = (v[j] - mean) * rstd * *(const f32x4*)(a.ln1_g + c0) + *(const f32x4*)(a.ln1_b + c0);
        if (X1BF) { v2u w; w.x = pk2(v[j].x, v[j].y); w.y = pk2(v[j].z, v[j].w); ((GAS v2u*)((bf16*)X1 + (size_t)m * D) + F.lane)[64 * j] = w; } else xo[64 * j] = v[j]; }
    row_stats(v, mean, rstd);
    const float* sh = ada + b * 6 * D + 3 * D; const float* sc = sh + D;
    GAS v2u* ho = (GAS v2u*)(H + (size_t)m * D) + F.lane;
#pragma unroll
    for (int j = 0; j < 8; ++j) { const int kg = F.lane + 64 * j, c0 = 4 * kg; const f32x4 y = (v[j] - mean) * rstd * (*(const f32x4*)(sc + c0) + 1.f) + *(const f32x4*)(sh + c0);
        if (FP8MOE) h8[64 * j] = pk4_fp8(y.x, y.y, y.z, y.w); else { v2u w; w.x = pk2(y.x, y.y); w.y = pk2(y.z, y.w); ho[64 * j] = w; }
        *(LAS f32x4*)(hT + (kg * 16 + (r ^ (kg & 15))) * 4) = y; }
}
__device__ __forceinline__ void phase_ln_router_mfma(const Frame& F, const Args& a) {
    const float* U = (const float*)(a.ws + WS_U); float* X1 = (float*)(a.ws + WS_X1); bf16* H = (bf16*)(a.ws + WS_H); const float* ada = (const float*)(a.ws + WS_ADA);
    int* TOPE = (int*)(a.ws + WS_TOPE); float* TOPW = (float*)(a.ws + WS_TOPW); int* HIST = (int*)(a.ws + WS_HIST);
    LAS float* hT = (LAS float*)F.lds;
    LAS float* Pp = (LAS float*)(F.lds + 131072);
    LAS int* cnt = (LAS int*)(F.lds + 131072 + 16384);
    const bf16* MIXG = (const bf16*)(a.ws + WS_U);
    URow va, vb2;
    if (F.bid < 256) { urow_load(va, a.x, MIXG, F.bid * 64 + 2 * F.wave, F.lane); urow_load(vb2, a.x, MIXG, F.bid * 64 + 2 * F.wave + 1, F.lane); }
    for (int vb = F.bid; vb < 256; vb += F.G) {
        __syncthreads();
        if (F.tid < NE) cnt[F.tid] = 0;
        for (int bt = 0; bt < 4; ++bt) {
            __syncthreads();
            const int mb = vb * 64 + bt * 16;
            lnr_stage_a(F, a, mb + 2 * F.wave, 2 * F.wave, va, hT, X1, H, ada);
            lnr_stage_a(F, a, mb + 2 * F.wave + 1, 2 * F.wave + 1, vb2, hT, X1, H, ada);
            __syncthreads();
            { const int nmb = (bt < 3) ? mb + 16 : (vb + F.G) * 64;
              if (nmb < M) { urow_load(va, a.x, MIXG, nmb + 2 * F.wave, F.lane); urow_load(vb2, a.x, MIXG, nmb + 2 * F.wave + 1, F.lane); } }
            { const int i = F.lane & 15, kk = F.lane >> 4; f32x4 acc0 = (f32x4){0.f, 0.f, 0.f, 0.f}, acc1 = (f32x4){0.f, 0.f, 0.f, 0.f};
              const float* wp = a.w_router + (size_t)(256 * F.wave + kk) * NE + i;
#pragma unroll 8
              for (int ks = 0; ks < 64; ++ks) { const int kg = 64 * F.wave + ks; const float av = hT[(kg * 16 + (i ^ (kg & 15))) * 4 + kk];
                  const float b0 = wp[(size_t)ks * 4 * NE], b1 = wp[(size_t)ks * 4 * NE + 16];
                  acc0 = __builtin_amdgcn_mfma_f32_16x16x4f32(av, b0, acc0, 0, 0, 0); acc1 = __builtin_amdgcn_mfma_f32_16x16x4f32(av, b1, acc1, 0, 0, 0); }
#pragma unroll
              for (int rg = 0; rg < 4; ++rg) { Pp[(F.wave * 16 + 4 * kk + rg) * 32 + i] = acc0[rg]; Pp[(F.wave * 16 + 4 * kk + rg) * 32 + 16 + i] = acc1[rg]; } }
            __syncthreads();
            for (int rr = 0; rr < 2; ++rr) {
                const int r = 2 * F.wave + rr, m = mb + r; const int e = F.lane & 31;
                float val = a.b_router[e];
#pragma unroll
                for (int w2 = 0; w2 < 8; ++w2) val += Pp[(w2 * 16 + r) * 32 + e];
                if (F.lane >= 32) val = -INFINITY;
                float sv[4]; int si[4];
#pragma unroll
                for (int q = 0; q < 4; ++q) { float mv = val; int mi = F.lane;
#pragma unroll
                    for (int o = 1; o < 32; o <<= 1) { const float ov = __shfl_xor(mv, o); const int oi = __shfl_xor(mi, o); if (ov > mv || (ov == mv && oi < mi)) { mv = ov; mi = oi; } }
                    mv = __shfl(mv, 0); mi = __shfl(mi, 0); sv[q] = mv; si[q] = mi; if (F.lane == mi) val = -INFINITY; }
                const float e1 = __expf(sv[1] - sv[0]), e2 = __expf(sv[2] - sv[0]), e3 = __expf(sv[3] - sv[0]), inv = 1.f / (1.f + e1 + e2 + e3);
                if (F.lane == 0) { *(int4*)(TOPE + (size_t)m * 4) = make_int4(si[0], si[1], si[2], si[3]); *(f32x4*)(TOPW + (size_t)m * 4) = (f32x4){inv, e1 * inv, e2 * inv, e3 * inv};
                    atomicAdd((int*)&cnt[si[0]], 1); atomicAdd((int*)&cnt[si[1]], 1); atomicAdd((int*)&cnt[si[2]], 1); atomicAdd((int*)&cnt[si[3]], 1); }
            }
        }
        __syncthreads();
        if (F.tid < NE) HIST[vb * NE + F.tid] = cnt[F.tid];
    }
    __syncthreads();
}
__device__ __forceinline__ void phase_moe_sort(const Frame& F, const Args& a) {
    const int* TOPE = (const int*)(a.ws + WS_TOPE); const float* TOPW = (const float*)(a.ws + WS_TOPW); const int* HIST = (const int*)(a.ws + WS_HIST);
    int* POS = (int*)(a.ws + WS_POS); float* ROWW = (float*)(a.ws + WS_ROWW); int* ROWTOK = (int*)(a.ws + WS_ROWW + 512 * 1024); const bf16* H = (const bf16*)(a.ws + WS_H); bf16* XS = (bf16*)(a.ws + WS_XS);
    int* PADG = (int*)(a.ws + WS_CTL) + CW_PAD;
    LAS int* tot = (LAS int*)F.lds; LAS int* bef = tot + 32; LAS int* pst = tot + 64; LAS int* ent = tot + 128; LAS int* pos = tot + 384; LAS int* ptot = tot + 640; LAS int* pbef = tot + 1152; LAS int* cntw = tot + 1664;
    for (int vb = F.bid; vb < 256; vb += F.G) {
        __syncthreads();
        { const int e = F.tid & 31, part = F.tid >> 5; int t = 0, bsum = 0;
#pragma unroll
          for (int i = 0; i < 16; ++i) { const int v = part * 16 + i; const int c = HIST[v * NE + e]; t += c; if (v < vb) bsum += c; }
          ptot[part * 32 + e] = t; pbef[part * 32 + e] = bsum; }
        __syncthreads();
        if (F.tid < NE) { int t = 0, bsum = 0;
#pragma unroll
          for (int p = 0; p < 16; ++p) { t += ptot[p * 32 + F.tid]; bsum += pbef[p * 32 + F.tid]; }
          tot[F.tid] = t; bef[F.tid] = bsum; }
        if (F.tid < 256) ent[F.tid] = TOPE[(size_t)vb * 256 + F.tid];
        __syncthreads();
        if (F.tid == 0) { int run = 0; for (int e = 0; e < NE; ++e) { pst[e] = run; run += ((tot[e] + 255) / 256) * 256; } pst[NE] = run; }
        __syncthreads();
        if (vb == 0 && F.tid <= NE) PADG[F.tid] = pst[F.tid];
        int myrank = 0; const int mye = (F.tid < 256) ? ent[F.tid] : -1;
        if (F.tid < 256) {
#pragma unroll 8
            for (int e = 0; e < NE; ++e) { const unsigned long long mk = __ballot(mye == e); if (mye == e) myrank = __popcll(mk & ((1ull << F.lane) - 1ull)); if (F.lane == 0) cntw[F.wave * NE + e] = __popcll(mk); }
        }
        __syncthreads();
        if (F.tid < 256) { int base = pst[mye] + bef[mye]; for (int w2 = 0; w2 < F.wave; ++w2) base += cntw[w2 * NE + mye]; pos[F.tid] = base + myrank; }
        __syncthreads();
        if (F.tid < 256) { const int p = pos[F.tid]; POS[(size_t)vb * 256 + F.tid] = p; ROWW[p] = TOPW[(size_t)vb * 256 + F.tid]; ROWTOK[p] = vb * 64 + (F.tid >> 2); }
        if (vb == 0 && F.tid < NE) { for (int p = pst[F.tid] + tot[F.tid]; p < pst[F.tid + 1]; ++p) { ROWTOK[p] = 0; ROWW[p] = 0.f; } }
#if !(FAST & 512)
        for (int i = F.wave; i < 256; i += 8) { const int p = pos[i], tok = vb * 64 + (i >> 2);
            const GAS v4u* src = (const GAS v4u*)(H + (size_t)tok * D) + F.lane; GAS v4u* dst = (GAS v4u*)(XS + (size_t)p * D) + F.lane;
#pragma unroll
            for (int q = 0; q < 4; ++q) dst[64 * q] = src[64 * q]; }
#endif
    }
    __syncthreads();
}
struct EpiSwiglu { const float* bgu; bf16* act;
    __device__ __forceinline__ void operator()(const STile& t, int row, int col, float g, float u) const {
        const float* be = bgu + (size_t)t.aux * 2 * FF; g += be[2 * col]; u += be[2 * col + 1];
        g = fminf(g, 7.f); u = fminf(fmaxf(u, -7.f), 7.f);
        act[(size_t)row * FF + col] = (bf16)f2bf((u + 1.f) * g * sigmoidf_(1.702f * g)); } };
struct EpiDown { const float* bd; const float* roww; bf16* ys;
    __device__ __forceinline__ void operator()(const STile& t, int row, int col, float v, float) const { ys[(size_t)row * D + col] = (bf16)f2bf((v + bd[(size_t)t.aux * D + col]) * roww[row]); } };
__device__ __forceinline__ void phase_combine(const Frame& F, const Args& a) {
    const float* X1 = (const float*)(a.ws + WS_X1); const bf16* YS = (const bf16*)(a.ws + WS_YS); const int* POS = (const int*)(a.ws + WS_POS); const float* ada = (const float*)(a.ws + WS_ADA);
    const int gw = F.bid * 8 + F.wave, NGW = F.G * 8;
    for (int m = gw; m < M; m += NGW) {
        const int b = m / T; const int4 ps = *(const int4*)(POS + (size_t)m * 4);
        f32x4 v[8];
        if (X1BF) { const GAS v2u* xp = (const GAS v2u*)((const bf16*)X1 + (size_t)m * D) + F.lane;
#pragma unroll
            for (int j = 0; j < 8; ++j) { const v2u r = xp[64 * j]; v[j] = (f32x4){bflo(r.x), bfhi(r.x), bflo(r.y), bfhi(r.y)}; } }
        else load_row(X1 + (size_t)m * D, F.lane, v);
        const GAS v2u* y0 = (const GAS v2u*)(YS + (size_t)ps.x * D) + F.lane; const GAS v2u* y1 = (const GAS v2u*)(YS + (size_t)ps.y * D) + F.lane;
        const GAS v2u* y2 = (const GAS v2u*)(YS + (size_t)ps.z * D) + F.lane; const GAS v2u* y3 = (const GAS v2u*)(YS + (size_t)ps.w * D) + F.lane;
        const float* gt = ada + b * 6 * D + 5 * D;
#pragma unroll
        for (int j = 0; j < 8; ++j) { const int c0 = 4 * (F.lane + 64 * j);
#if YS8
            const unsigned q0 = ((const GAS unsigned*)((const unsigned char*)YS + (size_t)ps.x * D) + F.lane)[64 * j], q1 = ((const GAS unsigned*)((const unsigned char*)YS + (size_t)ps.y * D) + F.lane)[64 * j];
            const unsigned q2 = ((const GAS unsigned*)((const unsigned char*)YS + (size_t)ps.z * D) + F.lane)[64 * j], q3 = ((const GAS unsigned*)((const unsigned char*)YS + (size_t)ps.w * D) + F.lane)[64 * j];
            typedef float v2f_t __attribute__((__vector_size__(8)));
            v2f_t lo = __builtin_amdgcn_cvt_pk_f32_fp8((int)q0, false), hi = __builtin_amdgcn_cvt_pk_f32_fp8((int)q0, true);
            lo += __builtin_amdgcn_cvt_pk_f32_fp8((int)q1, false); hi += __builtin_amdgcn_cvt_pk_f32_fp8((int)q1, true);
            lo += __builtin_amdgcn_cvt_pk_f32_fp8((int)q2, false); hi += __builtin_amdgcn_cvt_pk_f32_fp8((int)q2, true);
            lo += __builtin_amdgcn_cvt_pk_f32_fp8((int)q3, false); hi += __builtin_amdgcn_cvt_pk_f32_fp8((int)q3, true);
            const f32x4 f = (f32x4){lo[0], lo[1], hi[0], hi[1]} * 0.0625f;
#else
            const v2u r0 = y0[64 * j], r1 = y1[64 * j], r2 = y2[64 * j], r3 = y3[64 * j];
            f32x4 f = (f32x4){bflo(r0.x), bfhi(r0.x), bflo(r0.y), bfhi(r0.y)}; f += (f32x4){bflo(r1.x), bfhi(r1.x), bflo(r1.y), bfhi(r1.y)};
            f += (f32x4){bflo(r2.x), bfhi(r2.x), bflo(r2.y), bfhi(r2.y)}; f += (f32x4){bflo(r3.x), bfhi(r3.x), bflo(r3.y), bfhi(r3.y)};
#endif
            v[j] = v[j] * DN_ALPHA + *(const f32x4*)(gt + c0) * f; }
        float mean, rstd; row_stats(v, mean, rstd);
        GAS f32x4* o = (GAS f32x4*)(a.out + (size_t)m * D) + F.lane;
#pragma unroll
        for (int j = 0; j < 8; ++j) { const int c0 = 4 * (F.lane + 64 * j); o[64 * j] = (v[j] - mean) * rstd * *(const f32x4*)(a.ln2_g + c0) + *(const f32x4*)(a.ln2_b + c0); }
    }
}

constexpr int N_PHASES = 13;
__global__ void __launch_bounds__(512, 2) fwd(Args args) {
    extern __shared__ __attribute__((aligned(16))) unsigned char lds_raw[];
    Frame F; F.lds = (LAS unsigned char*)lds_raw; F.tid = threadIdx.x; F.lane = F.tid & 63; F.wave = __builtin_amdgcn_readfirstlane(F.tid >> 6); F.G = gridDim.x; F.bid = blockIdx.x;
    volatile LAS unsigned* MISC = (volatile LAS unsigned*)(F.lds + MISC_OFF);
    if (F.tid < 32) MISC[F.tid] = 0u;
    __syncthreads();
    unsigned* ctl = (unsigned*)(args.ws + WS_CTL);
    XcdBarrier bar; bar.bar = ctl + CW_BAR; bar.x = 0; bar.st = nullptr;
    if (MK_ONE_LAUNCH) bar = xcd_barrier_post(ctl + CW_BAR, MISC + 8);
    const int lo = args.ph_lo, hi = args.ph_hi;
    unsigned char* ws = args.ws;
#ifndef PH_MASK
#define PH_MASK 0x1fff
#endif
#define IN(k) (((PH_MASK >> (k)) & 1) && lo <= (k) && (k) < hi)
#define SEAM(k) do { if (IN(k) && IN((k) + 1)) xcd_barrier(bar); } while (0)
    if (IN(0)) { REPN(0) phase_prologue(F, args); } SEAM(0);
    if (IN(1)) { REPN(1) phase_lnmod1(F, args); } SEAM(1);
    if (IN(2)) {
#if FAST & 1
        const int ng = (NCONV > 0 && F.G > NCONV && (F.G % 8) == 0) ? F.G - NCONV : F.G;
        if (F.bid < ng) {
            constexpr int NBF = NPAD;
            pg8::Gemm g{(const bf16*)(ws + WS_H), (const bf16*)(ws + WS_WINT), M, NBF, D}; pg8::SkipOrder S; S.init(M, (T8LO + 1) * 256, ng, F.bid); S.t8 = T8LO; pg8::EpiProjF E{(bf16*)(ws + WS_PROJ), (float*)(ws + WS_ALR), (bf16*)(ws + WS_QAF), (bf16*)(ws + WS_KAF), (bf16*)(ws + WS_VAF), (bf16*)(ws + WS_VGT)};
#if ALR8
            static_assert(!ALR8 || C8_LO == 0, "ALR8 needs the whole in-projection in the fp8 call");
            { (void)g; (void)S; pg8::Gemm g8{(const bf16*)(ws + WS_H8A), (const bf16*)(ws + WS_WG8), M, N8 + 256, D, 0x7f7f7f7fu, 0x79797979u}; pg8::GateOrder8 S8; S8.init(M, N8 + 256, ng, F.bid); S8.t8 = 0;
              pg8::gemm_phase<pg8::EpiProjF, pg8::GateOrder8, true, true, false, 1>(F.lds, g8, S8, E); }
            if (HELP_PAIRS > 0 && F.G == 256) { if (F.bid >= HELP_LO) phase_convert_moe_dma(F, args, F.bid - HELP_LO, ng - HELP_LO, CONV_PAIRS - HELP_PAIRS, HELP_B);
                else phase_convert_moe_dma(F, args, F.bid, HELP_LO, CONV_PAIRS - HELP_A, HELP_A); }
#elif FP8GATE
            REPN(2) pg8::gemm_phase<pg8::EpiProjF, pg8::SkipOrder, true, true>(F.lds, g, S, E);
            { pg8::Gemm g8{(const bf16*)(ws + WS_H8A), (const bf16*)(ws + WS_WG8), M, N8, D, 0x7f7f7f7fu, 0x79797979u}; pg8::GateOrder8 S8; S8.init(M, N8, ng, ng - 8 - (F.bid & ~7) + (F.bid & 7)); S8.t8 = T8LO;
              pg8::gemm_phase<pg8::EpiProjF, pg8::GateOrder8, true, true, false, 1>(F.lds, g8, S8, E); }
#endif
            if (ng == F.G) phase_convert_moe(F, args, F.bid, F.G);
        } else {
#if FP8MOE && CONV_DMA
            phase_convert_moe_dma(F, args, F.bid - ng, F.G - ng, 0, CONV_PAIRS - HELP_PAIRS);
#else
            phase_convert_moe(F, args, F.bid - ng, F.G - ng);
#endif
        }
#else
        DenseTiles TL{(const bf16*)(ws + WS_H), (const bf16*)(ws + WS_WINT), M, NPAD, D}; EpiProj E{(bf16*)(ws + WS_PROJ), (float*)(ws + WS_ALR), (bf16*)(ws + WS_VAT), (bf16*)(ws + WS_VGT), (bf16*)(ws + WS_QAF), (bf16*)(ws + WS_KAF), (bf16*)(ws + WS_VAF)}; sgemm_phase<false>(F, D, TL, E);
        phase_convert_moe(F, args, F.bid, F.G);
#endif
    } SEAM(2);
    if (IN(3)) {
#ifndef NO3A
#if FAST & 64
        REPN(3) phase_attn_mfma(F, args);
#else
        REPN(3) phase_attn_simple(F, args);
#endif
#endif
#ifndef NO3B
#if FAST & 128
        REPN(14) phase_gla_prep_mfma(F, args);
#else
        REPN(14) phase_gla_prep_simple(F, args);
#endif
#endif
    } SEAM(3);
    if (IN(4)) {
#if FAST & 128
        REPN(4) phase_gla_scan_mfma(F, args);
#else
        REPN(4) phase_gla_scan_simple(F, args);
#endif
#if FAST & 2
#if FP8PA
        pg8::Gemm g{(const bf16*)(ws + WS_YATT), (const bf16*)(ws + WS_PA8), M, D, 1024, 0x7b7b7b7bu, 0x79797979u}; pg8::StaticOrder S; S.init(M, D, F.G, F.bid); pg8::EpiT1F E{(const bf16*)(ws + WS_PROJ), (bf16*)(ws + WS_T1)};
        pg8::gemm_phase<pg8::EpiT1F, pg8::StaticOrder, true, true, false, 1>(F.lds, g, S, E);
#else
        pg8::Gemm g{(const bf16*)(ws + WS_YATT), (const bf16*)(ws + WS_PAT), M, D, 1024}; pg8::StaticOrder S; S.init(M, D, F.G, F.bid); pg8::EpiT1F E{(const bf16*)(ws + WS_PROJ), (bf16*)(ws + WS_T1)};
        pg8::gemm_phase<pg8::EpiT1F, pg8::StaticOrder, true, true>(F.lds, g, S, E);
#endif
#else
        DenseTiles TL{(const bf16*)(ws + WS_YATT), (const bf16*)(ws + WS_PAT), M, D, 1024}; EpiT1 E{(const bf16*)(ws + WS_PROJ), (bf16*)(ws + WS_T1)}; sgemm_phase<false>(F, 1024, TL, E);
#endif
    } SEAM(4);
    if (IN(5)) { REPN(5) phase_gla_finish(F, args); } SEAM(5);
    if (IN(6)) {
#if FAST & 4
#if FP8PG
        pg8::Gemm g{(const bf16*)(ws + WS_YGLA), (const bf16*)(ws + WS_PG8), M, D, D, 0x7c7c7c7cu, 0x79797979u}; pg8::StaticOrder S; S.init(M, D, F.G, F.bid); pg8::EpiMergedF E{(const bf16*)(ws + WS_PROJ), (const bf16*)(ws + WS_T1), (bf16*)(ws + WS_MERGED)};
        REPN(6) pg8::gemm_phase<pg8::EpiMergedF, pg8::StaticOrder, true, true, false, 1>(F.lds, g, S, E);
#else
        pg8::Gemm g{(const bf16*)(ws + WS_YGLA), (const bf16*)(ws + WS_PGT), M, D, D}; pg8::StaticOrder S; S.init(M, D, F.G, F.bid); pg8::EpiMergedF E{(const bf16*)(ws + WS_PROJ), (const bf16*)(ws + WS_T1), (bf16*)(ws + WS_MERGED)};
        REPN(6) pg8::gemm_phase<pg8::EpiMergedF, pg8::StaticOrder, true, true>(F.lds, g, S, E);
#endif
#else
        DenseTiles TL{(const bf16*)(ws + WS_YGLA), (const bf16*)(ws + WS_PGT), M, D, D}; EpiMerged E{(const bf16*)(ws + WS_PROJ), (const bf16*)(ws + WS_T1), (bf16*)(ws + WS_MERGED)}; sgemm_phase<false>(F, D, TL, E);
#endif
    } SEAM(6);
    if (IN(7)) {
#if FAST & 8
#if FP8WO
        pg8::Gemm g{(const bf16*)(ws + WS_MERGED), (const bf16*)(ws + WS_WO8), M, D, D, 0x7b7b7b7bu, 0x79797979u}; pg8::StaticOrder S; S.init(M, D, F.G, F.bid); pg8::EpiUF E{(const float*)(ws + WS_ADA), (bf16*)(ws + WS_U)};
        REPN(7) pg8::gemm_phase<pg8::EpiUF, pg8::StaticOrder, true, true, false, 1>(F.lds, g, S, E);
#else
        pg8::Gemm g{(const bf16*)(ws + WS_MERGED), (const bf16*)(ws + WS_WOT), M, D, D}; pg8::StaticOrder S; S.init(M, D, F.G, F.bid); pg8::EpiUF E{(const float*)(ws + WS_ADA), (bf16*)(ws + WS_U)};
        REPN(7) pg8::gemm_phase<pg8::EpiUF, pg8::StaticOrder, true, true>(F.lds, g, S, E);
#endif
#else
        DenseTiles TL{(const bf16*)(ws + WS_MERGED), (const bf16*)(ws + WS_WOT), M, D, D}; EpiU E{args.x, (const float*)(ws + WS_ADA), (bf16*)(ws + WS_U)}; sgemm_phase<false>(F, D, TL, E);
#endif
    } SEAM(7);
    if (IN(8)) {
#if FAST & 256
        REPN(8) phase_ln_router_mfma(F, args);
#else
        REPN(8) phase_ln_router(F, args);
#endif
    } SEAM(8);
    if (IN(9)) { REPN(9) phase_moe_sort(F, args); } SEAM(9);
    if (IN(10)) {
#if FAST & 16
        const int* padg = (const int*)(ws + WS_CTL) + CW_PAD; LAS unsigned char* t2e = F.lds + 131072;
        const int nMt = __builtin_amdgcn_readfirstlane(padg[NE]) / 256;
        __syncthreads();
        for (int p = F.tid; p < nMt; p += 512) { int e = 0; for (int q = 1; q < NE; ++q) if (p * 256 >= padg[q]) e = q; t2e[p] = (unsigned char)e; }
        __syncthreads();
#if FP8MOE
        pg8::Gemm g{(const bf16*)(ws + WS_H8), (const bf16*)(ws + WS_WGU8), nMt * 256, 2 * FF, D, 0x7f7f7f7fu, 0x79797979u}; pg8::MoeOrder S; S.init(nMt * 256, 2 * FF, F.G, F.bid); S.NT = 2 * FF / 256; S.t2e = t2e;
        { LAS unsigned* gtab = (LAS unsigned*)(F.lds + 131072 + 1024); const int* rowtok = (const int*)(ws + WS_ROWW + 512 * 1024); S.gtab = gtab;
#pragma unroll
          for (int ps = 0; ps < 15; ++ps) { const int i = 2 * ps + (F.tid >> 8); pg8::Unit uu; if (S.next(i, uu)) gtab[i * 256 + (F.tid & 255)] = (unsigned)rowtok[uu.pm * 256 + (F.tid & 255)] * (unsigned)D; }
          __syncthreads(); }
        pg8::EpiSwiglu8 E{args.b_gate_up, ws + WS_ACT8};
        REPN(10) pg8::gemm_phase<pg8::EpiSwiglu8, pg8::MoeOrder, true, true, true, 1>(F.lds, g, S, E);
#elif FAST & 512
        pg8::Gemm g{(const bf16*)(ws + WS_H), (const bf16*)(ws + WS_WGUT), nMt * 256, 2 * FF, D}; pg8::MoeOrder S; S.init(nMt * 256, 2 * FF, F.G, F.bid); S.NT = 2 * FF / 256; S.t2e = t2e;
        { LAS unsigned* gtab = (LAS unsigned*)(F.lds + 131072 + 1024); const int* rowtok = (const int*)(ws + WS_ROWW + 512 * 1024); S.gtab = gtab;
#pragma unroll
          for (int ps = 0; ps < 15; ++ps) { const int i = 2 * ps + (F.tid >> 8); pg8::Unit uu; if (S.next(i, uu)) gtab[i * 256 + (F.tid & 255)] = (unsigned)rowtok[uu.pm * 256 + (F.tid & 255)] * (unsigned)(D * 2); }
          __syncthreads(); }
        pg8::EpiSwigluF E{args.b_gate_up, (bf16*)(ws + WS_ACT)};
        REPN(10) pg8::gemm_phase<pg8::EpiSwigluF, pg8::MoeOrder, true, true, true>(F.lds, g, S, E);
#else
        pg8::Gemm g{(const bf16*)(ws + WS_XS), (const bf16*)(ws + WS_WGUT), nMt * 256, 2 * FF, D}; pg8::MoeOrder S; S.init(nMt * 256, 2 * FF, F.G, F.bid); S.NT = 2 * FF / 256; S.t2e = t2e; S.gtab = nullptr;
        pg8::EpiSwigluF E{args.b_gate_up, (bf16*)(ws + WS_ACT)};
        REPN(10) pg8::gemm_phase<pg8::EpiSwigluF, pg8::MoeOrder, true, true>(F.lds, g, S, E);
#endif
#else
        MoeTiles TL{(const bf16*)(ws + WS_XS), (const bf16*)(ws + WS_WGUT), (const int*)(ws + WS_CTL) + CW_PAD, FF / 128, D, 2 * FF, true}; EpiSwiglu E{args.b_gate_up, (bf16*)(ws + WS_ACT)}; sgemm_phase<true>(F, D, TL, E);
#endif
    } SEAM(10);
    if (IN(11)) {
#if FAST & 32
        const int* padg = (const int*)(ws + WS_CTL) + CW_PAD; LAS unsigned char* t2e = F.lds + 131072;
        const int nMt = __builtin_amdgcn_readfirstlane(padg[NE]) / 256;
        __syncthreads();
        for (int p = F.tid; p < nMt; p += 512) { int e = 0; for (int q = 1; q < NE; ++q) if (p * 256 >= padg[q]) e = q; t2e[p] = (unsigned char)e; }
        __syncthreads();
#if FP8MOE
        pg8::Gemm g{(const bf16*)(ws + WS_ACT8), (const bf16*)(ws + WS_WDN8), nMt * 256, D, FF, 0x7d7d7d7du, 0x79797979u}; pg8::MoeOrder S; S.init(nMt * 256, D, F.G, F.bid); S.NT = D / 256; S.t2e = t2e; S.gtab = nullptr;
        pg8::EpiDownF E{args.b_down, (const float*)(ws + WS_ROWW), (bf16*)(ws + WS_YS)};
        REPN(11) pg8::gemm_phase<pg8::EpiDownF, pg8::MoeOrder, true, true, false, 1>(F.lds, g, S, E);
#else
        pg8::Gemm g{(const bf16*)(ws + WS_ACT), (const bf16*)(ws + WS_WDNT), nMt * 256, D, FF}; pg8::MoeOrder S; S.init(nMt * 256, D, F.G, F.bid); S.NT = D / 256; S.t2e = t2e; S.gtab = nullptr;
        pg8::EpiDownF E{args.b_down, (const float*)(ws + WS_ROWW), (bf16*)(ws + WS_YS)};
        REPN(11) pg8::gemm_phase<pg8::EpiDownF, pg8::MoeOrder, true, true>(F.lds, g, S, E);
#endif
#else
        MoeTiles TL{(const bf16*)(ws + WS_ACT), (const bf16*)(ws + WS_WDNT), (const int*)(ws + WS_CTL) + CW_PAD, D / 128, FF, D, false}; EpiDown E{args.b_down, (const float*)(ws + WS_ROWW), (bf16*)(ws + WS_YS)}; sgemm_phase<false>(F, FF, TL, E);
#endif
    } SEAM(11);
    if (IN(12)) { REPN(12) phase_combine(F, args); }
#undef IN
#undef SEAM
}

extern "C" void kernel_launch(void* const* d_in, const int* in_sizes, int n_in, void* d_out, int out_size, void* d_ws, size_t ws_size, hipStream_t stream) {
    static int grid = 0;
    if (grid == 0) {
        if (n_in != 22 || in_sizes[0] != M * D || out_size != M * D || ws_size < WS_END) { fprintf(stderr, "kernel_launch: unexpected shapes (n_in %d, in0 %d, out %d, ws %zu)\n", n_in, n_in > 0 ? in_sizes[0] : -1, out_size, ws_size); grid = -1; return; }
        int dev = 0, cus = 0, per_cu = 0;
        if (hipGetDevice(&dev) != hipSuccess || hipDeviceGetAttribute(&cus, hipDeviceAttributeMultiprocessorCount, dev) != hipSuccess) { grid = -1; return; }
        if (hipFuncSetAttribute((const void*)fwd, hipFuncAttributeMaxDynamicSharedMemorySize, LDS_BYTES) != hipSuccess) { fprintf(stderr, "kernel_launch: hipFuncSetAttribute failed\n"); grid = -1; return; }
        if (hipOccupancyMaxActiveBlocksPerMultiprocessor(&per_cu, (const void*)fwd, 512, LDS_BYTES) != hipSuccess || per_cu < 1) fprintf(stderr, "kernel_launch: occupancy query reports %d\n", per_cu);
        (void)hipGetLastError();
        grid = cus;
    }
    if (grid < 0) return;
    (void)hipMemsetAsync((char*)d_ws + WS_CTL, 0, CTL_ZERO_BYTES, stream);
    Args a{};
    const float** ap = (const float**)&a;
    for (int i = 0; i < 22; ++i) ap[i] = (const float*)d_in[i];
    a.out = (float*)d_out; a.ws = (unsigned char*)d_ws;
    if (MK_ONE_LAUNCH) { a.ph_lo = 0; a.ph_hi = N_PHASES; hipLaunchKernelGGL(fwd, dim3(grid), dim3(512), LDS_BYTES, stream, a); }
    else for (int p = 0; p < N_PHASES; ++p) { a.ph_lo = p; a.ph_hi = p + 1; hipLaunchKernelGGL(fwd, dim3(grid), dim3(512), LDS_BYTES, stream, a); }
}
```
